# Optimizing an MI355X kernel written in HIP

```python
import jax, jax.numpy as jnp
from jax import lax
import numpy as np

D_MODEL = 1024
BATCH = 2
SEQ = 8192
DEPTH = 2

GLA_HEADS = 4
GLA_DK = D_MODEL // 2 // GLA_HEADS
GLA_DV = D_MODEL // GLA_HEADS
GLA_GATE_RANK = 16
GLA_TAU = 16.0
GLA_CHUNK = 64

NSA_HEADS = 16
NSA_GROUPS = 4
NSA_HPG = NSA_HEADS // NSA_GROUPS
NSA_HEAD_DIM = D_MODEL // NSA_HEADS
CMP_BLOCK = 32
CMP_STRIDE = 16
CMP_HIDDEN = 256
SLC_BLOCK = 64
SLC_TOP_N = 16
WINDOW = 512
Q_BLOCK = 128

ROPE_THETA = 500000.0
ROT_DIM = NSA_HEAD_DIM // 4

N_EXPERTS = 16
N_EXPERT_GROUPS = 4
EXPERTS_PER_GROUP = N_EXPERTS // N_EXPERT_GROUPS
TOP_K = 2
D_FF_EXPERT = D_MODEL // 4

DN_ALPHA = (2 * DEPTH) ** 0.25
DN_BETA = (8 * DEPTH) ** -0.25
LN_EPS = 1e-5
NEG = -1e30
BIG = 1e30

N_GLA_LAYERS = (DEPTH + 1) // 2
N_NSA_LAYERS = DEPTH // 2
GLA_IN = 2 * GLA_HEADS * GLA_DK + 2 * GLA_HEADS * GLA_DV + GLA_GATE_RANK
NSA_IN = NSA_HEADS * NSA_HEAD_DIM + 6 * NSA_GROUPS * NSA_HEAD_DIM + 3 * NSA_HEADS

kernel_name = 'hybrid_gla_nsa_moe_deepnorm'


def layer_norm(x, g, b):
    xf = x.astype(jnp.float32)
    mu = jnp.mean(xf, axis=-1, keepdims=True)
    var = jnp.mean(jnp.square(xf - mu), axis=-1, keepdims=True)
    y = (xf - mu) * lax.rsqrt(var + LN_EPS) * g.astype(jnp.float32) + b.astype(jnp.float32)
    return y.astype(x.dtype)


def partial_rope(t, pos):
    half = ROT_DIM // 2
    inv_freq = jnp.power(ROPE_THETA, -jnp.arange(half, dtype=jnp.float32) * (2.0 / ROT_DIM))
    ang = pos.astype(jnp.float32)[:, None] * inv_freq[None, :]
    cos = jnp.cos(ang).astype(t.dtype)
    sin = jnp.sin(ang).astype(t.dtype)
    x1 = t[..., :half]
    x2 = t[..., half:ROT_DIM]
    return jnp.concatenate([x1 * cos - x2 * sin, x2 * cos + x1 * sin, t[..., ROT_DIM:]], axis=-1)


def masked_softmax(scores, mask):
    return jax.nn.softmax(jnp.where(mask, scores.astype(jnp.float32), NEG), axis=-1)


def gla_mixer(x, w_in, w_gate_up, b_gate, norm_g, w_out):
    B, S, _ = x.shape
    H, DK, DV, C = GLA_HEADS, GLA_DK, GLA_DV, GLA_CHUNK
    N = S // C
    f32 = jnp.float32
    proj = x @ w_in
    cuts = np.cumsum([H * DK, H * DK, H * DV, GLA_GATE_RANK]).tolist()
    q, k, v, g_low, r = jnp.split(proj, cuts, axis=-1)
    log_a = jax.nn.log_sigmoid((g_low @ w_gate_up + b_gate).astype(f32)) / GLA_TAU

    def chunks(t, d):
        return t.reshape(B, N, C, H, d).transpose(0, 3, 1, 2, 4).astype(f32)

    q = chunks(q, DK) * (DK ** -0.5)
    k = chunks(k, DK)
    v = chunks(v, DV)
    b = jnp.cumsum(chunks(log_a, DK), axis=3)
    b_last = b[:, :, :, -1:, :]
    q_dec = q * jnp.exp(b)
    causal = jnp.tril(jnp.ones((C, C), dtype=bool))
    scores = jnp.einsum('bhnid,bhnjd->bhnij', q_dec, k * jnp.exp(-b))
    o_intra = jnp.einsum('bhnij,bhnjv->bhniv', jnp.where(causal, scores, 0.0), v)
    kv = jnp.einsum('bhncd,bhncv->bhndv', k * jnp.exp(b_last - b), v)
    decay = jnp.exp(b_last[:, :, :, 0, :])

    def step(state, inp):
        dec, kv_n = inp
        return dec[..., None] * state + kv_n, state

    _, states = lax.scan(step, jnp.zeros((B, H, DK, DV), f32),
                         (jnp.moveaxis(decay, 2, 0), jnp.moveaxis(kv, 2, 0)))
    o_inter = jnp.einsum('bhncd,nbhdv->bhncv', q_dec, states)
    o = (o_intra + o_inter).transpose(0, 2, 3, 1, 4).reshape(B, S, H, DV)
    o = o * lax.rsqrt(jnp.mean(jnp.square(o), axis=-1, keepdims=True) + LN_EPS) * norm_g.astype(f32)
    o = o.reshape(B, S, H * DV) * jax.nn.silu(r.astype(f32))
    return o.astype(x.dtype) @ w_out


def compress(t, w1, w2, pe):
    B, G, S, Dh = t.shape
    n_chunk = S // CMP_STRIDE
    span = CMP_BLOCK // CMP_STRIDE
    nc = n_chunk - span + 1
    ch = t.reshape(B, G, n_chunk, CMP_STRIDE, Dh)
    blocks = jnp.concatenate([ch[:, :, i:i + nc] for i in range(span)], axis=3)
    blocks = (blocks + pe).reshape(B, G, nc, CMP_BLOCK * Dh)
    return jax.nn.silu(blocks @ w1) @ w2


def nsa_mixer(x, w_in, w_ck1, w_ck2, w_cv1, w_cv2, cmp_pe, w_out):
    B, S, _ = x.shape
    H, G, HPG, Dh = NSA_HEADS, NSA_GROUPS, NSA_HPG, NSA_HEAD_DIM
    f32 = jnp.float32
    proj = x @ w_in
    cuts = np.cumsum([H * Dh] + [G * Dh] * 6).tolist()
    q, kc, vc, ks, vs, kw, vw, gates = jnp.split(proj, cuts, axis=-1)
    pos = jnp.arange(S, dtype=jnp.int32)

    def kv_heads(t):
        return t.reshape(B, S, G, Dh).transpose(0, 2, 1, 3)

    q = partial_rope(q.reshape(B, S, G, HPG, Dh).transpose(0, 2, 3, 1, 4), pos) * (Dh ** -0.5)
    gates = jax.nn.sigmoid(gates.astype(f32)).reshape(B, S, G, HPG, 3).transpose(0, 2, 3, 1, 4)

    span = CMP_BLOCK // CMP_STRIDE
    nc = S // CMP_STRIDE - span + 1
    cmp_end = jnp.arange(nc, dtype=jnp.int32) * CMP_STRIDE + (CMP_BLOCK - 1)
    k_cmp = partial_rope(compress(kv_heads(kc), w_ck1, w_ck2, cmp_pe), cmp_end)
    v_cmp = compress(kv_heads(vc), w_cv1, w_cv2, cmp_pe).astype(f32)

    ns = S // SLC_BLOCK
    n_sel = min(SLC_TOP_N, ns)
    k_slc = partial_rope(kv_heads(ks), pos).reshape(B, G, ns, SLC_BLOCK, Dh)
    v_slc = kv_heads(vs).reshape(B, G, ns, SLC_BLOCK, Dh)
    ratio = SLC_BLOCK // CMP_STRIDE
    pad_amt = ratio * ns + span - 1 - nc

    pad = ((0, 0), (0, 0), (WINDOW, 0), (0, 0))
    k_win = jnp.pad(partial_rope(kv_heads(kw), pos), pad)
    v_win = jnp.pad(kv_heads(vw), pad)

    bi = jnp.arange(B)[:, None, None, None]
    gi = jnp.arange(G)[None, :, None, None]
    blk_ids = jnp.arange(ns)
    in_blk = jnp.arange(SLC_BLOCK)
    win_off = jnp.arange(WINDOW + Q_BLOCK) - WINDOW

    def query_block(qi):
        s0 = qi * Q_BLOCK
        qpos = s0 + jnp.arange(Q_BLOCK)
        qb = lax.dynamic_slice_in_dim(q, s0, Q_BLOCK, axis=3)
        gb = lax.dynamic_slice_in_dim(gates, s0, Q_BLOCK, axis=3)

        cmask = cmp_end[None, :] <= qpos[:, None]
        p_cmp = masked_softmax(jnp.einsum('bghqd,bgcd->bghqc', qb, k_cmp), cmask)
        p_cmp = p_cmp * jnp.any(cmask, axis=-1)[:, None]
        o_cmp = jnp.einsum('bghqc,bgcd->bghqd', p_cmp, v_cmp)

        p_grp = jnp.pad(p_cmp.sum(axis=2), ((0, 0), (0, 0), (0, 0), (0, pad_amt)))
        imp = p_grp[..., 0:ratio * ns:ratio]
        for m in range(ratio):
            for n in range(span):
                if m + n > 0:
                    imp = imp + p_grp[..., m + n:m + n + ratio * ns:ratio]
        cur = (qpos // SLC_BLOCK)[:, None]
        forced = (blk_ids == 0) | (blk_ids == cur) | (blk_ids == cur - 1)
        imp = jnp.where(blk_ids <= cur, jnp.where(forced, BIG, imp), NEG)
        _, sel = lax.top_k(imp, n_sel)
        k_sel = k_slc[bi, gi, sel].reshape(B, G, Q_BLOCK, n_sel * SLC_BLOCK, Dh)
        v_sel = v_slc[bi, gi, sel].reshape(B, G, Q_BLOCK, n_sel * SLC_BLOCK, Dh)
        kpos = (sel[..., None] * SLC_BLOCK + in_blk).reshape(B, G, Q_BLOCK, n_sel * SLC_BLOCK)
        smask = (kpos <= qpos[:, None])[:, :, None]
        p_slc = masked_softmax(jnp.einsum('bghqd,bgqkd->bghqk', qb, k_sel), smask)
        o_slc = jnp.einsum('bghqk,bgqkd->bghqd', p_slc, v_sel.astype(f32))

        kw_b = lax.dynamic_slice_in_dim(k_win, s0, WINDOW + Q_BLOCK, axis=2)
        vw_b = lax.dynamic_slice_in_dim(v_win, s0, WINDOW + Q_BLOCK, axis=2)
        kwpos = s0 + win_off
        rel = qpos[:, None] - kwpos[None, :]
        wmask = (rel >= 0) & (rel < WINDOW) & (kwpos[None, :] >= 0)
        p_win = masked_softmax(jnp.einsum('bghqd,bgkd->bghqk', qb, kw_b), wmask)
        o_win = jnp.einsum('bghqk,bgkd->bghqd', p_win, vw_b.astype(f32))

        o = gb[..., 0:1] * o_cmp + gb[..., 1:2] * o_slc + gb[..., 2:3] * o_win
        return o.astype(x.dtype)

    outs = lax.map(query_block, jnp.arange(S // Q_BLOCK))
    o = outs.transpose(1, 0, 4, 2, 3, 5).reshape(B, S, H * Dh)
    return o @ w_out


def moe_ffn(x, w_router, b_router, w_gate, w_up, w_down):
    B, S, D = x.shape
    xt = x.reshape(B * S, D)
    n = xt.shape[0]
    s = jax.nn.sigmoid((xt @ w_router).astype(jnp.float32))
    biased = s + b_router.astype(jnp.float32)
    grp_score = lax.top_k(biased.reshape(n, N_EXPERT_GROUPS, EXPERTS_PER_GROUP), TOP_K)[0].sum(-1)
    grp = jnp.argmax(grp_score, axis=-1)
    in_grp = (jnp.arange(N_EXPERTS) // EXPERTS_PER_GROUP)[None, :] == grp[:, None]
    _, top_e = lax.top_k(jnp.where(in_grp, biased, NEG), TOP_K)
    w = jnp.take_along_axis(s, top_e, axis=-1)
    w = w / jnp.sum(w, axis=-1, keepdims=True)
    gate = jnp.zeros((n, N_EXPERTS), jnp.float32).at[jnp.arange(n)[:, None], top_e].set(w)
    h = jax.nn.silu(jnp.einsum('nd,edf->nef', xt, w_gate)) * jnp.einsum('nd,edf->nef', xt, w_up)
    h = h * gate[:, :, None].astype(h.dtype)
    return jnp.einsum('nef,efd->nd', h, w_down).reshape(B, S, D)


def setup_inputs(seed: int = 0) -> dict:
    key = jax.random.key(seed)
    ks = jax.random.split(key, 20)
    f32 = jnp.float32

    def nrm(k, shape, scale):
        return jax.random.normal(k, shape, f32) * scale

    D = D_MODEL
    nG, nN = N_GLA_LAYERS, N_NSA_LAYERS
    cmp_in = CMP_BLOCK * NSA_HEAD_DIM
    return {
        'x': nrm(ks[0], (BATCH, SEQ, D), 1.0),
        'gla_w_in': nrm(ks[1], (nG, D, GLA_IN), D ** -0.5),
        'gla_w_gate_up': nrm(ks[2], (nG, GLA_GATE_RANK, GLA_HEADS * GLA_DK), GLA_GATE_RANK ** -0.5),
        'gla_b_gate': nrm(ks[3], (nG, GLA_HEADS * GLA_DK), 0.1),
        'gla_norm_g': 1.0 + nrm(ks[4], (nG, GLA_DV), 0.02),
        'gla_w_out': nrm(ks[5], (nG, GLA_HEADS * GLA_DV, D), DN_BETA * (GLA_HEADS * GLA_DV) ** -0.5),
        'nsa_w_in': nrm(ks[6], (nN, D, NSA_IN), D ** -0.5),
        'nsa_w_cmp_k1': nrm(ks[7], (nN, cmp_in, CMP_HIDDEN), cmp_in ** -0.5),
        'nsa_w_cmp_k2': nrm(ks[8], (nN, CMP_HIDDEN, NSA_HEAD_DIM), CMP_HIDDEN ** -0.5),
        'nsa_w_cmp_v1': nrm(ks[9], (nN, cmp_in, CMP_HIDDEN), cmp_in ** -0.5),
        'nsa_w_cmp_v2': nrm(ks[10], (nN, CMP_HIDDEN, NSA_HEAD_DIM), CMP_HIDDEN ** -0.5),
        'nsa_cmp_pe': nrm(ks[11], (nN, CMP_BLOCK, NSA_HEAD_DIM), 0.1),
        'nsa_w_out': nrm(ks[12], (nN, NSA_HEADS * NSA_HEAD_DIM, D), DN_BETA * (NSA_HEADS * NSA_HEAD_DIM) ** -0.5),
        'moe_w_router': nrm(ks[13], (D, N_EXPERTS), D ** -0.5),
        'moe_b_router': nrm(ks[14], (N_EXPERTS,), 0.01),
        'moe_w_gate': nrm(ks[15], (DEPTH, N_EXPERTS, D, D_FF_EXPERT), D ** -0.5),
        'moe_w_up': nrm(ks[16], (DEPTH, N_EXPERTS, D, D_FF_EXPERT), D ** -0.5),
        'moe_w_down': nrm(ks[17], (DEPTH, N_EXPERTS, D_FF_EXPERT, D), DN_BETA * D_FF_EXPERT ** -0.5),
        'ln_g': 1.0 + nrm(ks[18], (DEPTH, 2, D), 0.02),
        'ln_b': nrm(ks[19], (DEPTH, 2, D), 0.02),
    }


def reference(x, gla_w_in, gla_w_gate_up, gla_b_gate, gla_norm_g, gla_w_out,
              nsa_w_in, nsa_w_cmp_k1, nsa_w_cmp_k2, nsa_w_cmp_v1, nsa_w_cmp_v2, nsa_cmp_pe, nsa_w_out,
              moe_w_router, moe_b_router, moe_w_gate, moe_w_up, moe_w_down, ln_g, ln_b):
    for i in range(DEPTH):
        j = i // 2
        if i % 2 == 0:
            h = gla_mixer(x, gla_w_in[j], gla_w_gate_up[j], gla_b_gate[j], gla_norm_g[j], gla_w_out[j])
        else:
            h = nsa_mixer(x, nsa_w_in[j], nsa_w_cmp_k1[j], nsa_w_cmp_k2[j], nsa_w_cmp_v1[j],
                          nsa_w_cmp_v2[j], nsa_cmp_pe[j], nsa_w_out[j])
        x = layer_norm(DN_ALPHA * x + h, ln_g[i, 0], ln_b[i, 0])
        f = moe_ffn(x, moe_w_router, moe_b_router, moe_w_gate[i], moe_w_up[i], moe_w_down[i])
        x = layer_norm(DN_ALPHA * x + f, ln_g[i, 1], ln_b[i, 1])
    return x
```

```cpp
#include <hip/hip_runtime.h>
#include <hip/hip_cooperative_groups.h>
#include <cstdio>
#include <cstdint>
namespace cg = cooperative_groups;

#ifndef MK_ONE_LAUNCH
#define MK_ONE_LAUNCH 0
#endif

typedef unsigned short bf16_t;
typedef short bf16x8 __attribute__((ext_vector_type(8)));
typedef float f32x4 __attribute__((ext_vector_type(4)));

constexpr int DM = 1024, SEQ = 8192, NTOK = 16384;
constexpr float DN_ALPHA = 1.41421356237309515f;
constexpr float LN_EPS = 1e-5f;

constexpr size_t KiB = 1024, MiB = 1024 * 1024;
constexpr size_t WS_CTL = 0;
constexpr size_t WS_CNT = 14848;
constexpr size_t WS_ROPE = 64 * KiB;
constexpr size_t WS_WRT = 576 * KiB;
constexpr size_t WS_BIASC = 640 * KiB;
constexpr size_t WS_GLOW = 1 * MiB;
constexpr size_t WS_DEC = 2 * MiB;
constexpr size_t WS_PW = 2 * MiB + 512 * KiB;
constexpr size_t WS_KCMP = 3 * MiB;
constexpr size_t WS_VCMPT = 3 * MiB + 512 * KiB;
constexpr size_t WS_LIST = 4 * MiB;
constexpr size_t WS_GT = 5 * MiB;
constexpr size_t WS_W = 8 * MiB;
constexpr size_t W_GI = WS_W;
constexpr size_t W_GO = W_GI + (size_t)3200 * 1024 * 2;
constexpr size_t W_NI = W_GO + (size_t)1024 * 1024 * 2;
constexpr size_t W_NO = W_NI + (size_t)2688 * 1024 * 2;
constexpr size_t W_CK1 = W_NO + (size_t)1024 * 1024 * 2;
constexpr size_t W_CV1 = W_CK1 + (size_t)256 * 2048 * 2;
constexpr size_t W_CK2 = W_CV1 + (size_t)256 * 2048 * 2;
constexpr size_t W_CV2 = W_CK2 + (size_t)64 * 256 * 2;
constexpr size_t W_MOE = W_CV2 + (size_t)64 * 256 * 2;
constexpr size_t MOE_E_BYTES = (size_t)(512 * 1024 + 1024 * 256) * 2;
constexpr size_t W_END = W_MOE + 16 * MOE_E_BYTES;
constexpr size_t WS_B = 50 * MiB;
constexpr size_t WS_C = 82 * MiB;
constexpr size_t WS_D = 178 * MiB;
constexpr size_t WS_END = 242 * MiB;
static_assert(W_END <= WS_B, "weights overflow");
constexpr size_t C_QK = WS_C;
constexpr size_t C_VT = WS_C + 32 * MiB;
constexpr size_t C_R = WS_C + 64 * MiB;
constexpr size_t C_QN = WS_C;
constexpr size_t C_KC = WS_C + 32 * MiB;
constexpr size_t C_VC = C_KC + 8 * MiB;
constexpr size_t C_KS = C_VC + 8 * MiB;
constexpr size_t C_VST = C_KS + 8 * MiB;
constexpr size_t C_KW = C_VST + 8 * MiB;
constexpr size_t C_VWT = C_KW + 8 * MiB;

constexpr int LDS_BYTES = 68 * 1024;
constexpr int NPHASE = 16;

struct Params {
    const float* in[20];
    float* out;
    unsigned char* ws;
    int ph_lo, ph_hi;
};

extern __shared__ __attribute__((aligned(16))) unsigned char smem_dyn[];

__device__ __forceinline__ bf16_t f2bf(float f) {
    unsigned u = __float_as_uint(f);
    u += 0x7FFFu + ((u >> 16) & 1u);
    return (bf16_t)(u >> 16);
}
__device__ __forceinline__ float bf2f(bf16_t h) { return __uint_as_float(((unsigned)h) << 16); }
__device__ __forceinline__ unsigned pack2(float lo, float hi) { return (unsigned)f2bf(lo) | ((unsigned)f2bf(hi) << 16); }
__device__ __forceinline__ float silu_f(float x) { return x / (1.f + __expf(-x)); }
__device__ __forceinline__ float sigmoid_f(float x) { return 1.f / (1.f + expf(-x)); }
__device__ __forceinline__ float logsig_f(float z) { return fminf(z, 0.f) - log1pf(expf(-fabsf(z))); }
__device__ __forceinline__ float rmax16(float v) {
    v = fmaxf(v, __shfl_xor(v, 1)); v = fmaxf(v, __shfl_xor(v, 2)); v = fmaxf(v, __shfl_xor(v, 4)); v = fmaxf(v, __shfl_xor(v, 8)); return v;
}
__device__ __forceinline__ float rsum16(float v) {
    v += __shfl_xor(v, 1); v += __shfl_xor(v, 2); v += __shfl_xor(v, 4); v += __shfl_xor(v, 8); return v;
}
__device__ __forceinline__ float wsum64(float v) {
    v += __shfl_xor(v, 1); v += __shfl_xor(v, 2); v += __shfl_xor(v, 4); v += __shfl_xor(v, 8); v += __shfl_xor(v, 16); v += __shfl_xor(v, 32); return v;
}
__device__ __forceinline__ void glds16(const void* g, void* l) {
    __builtin_amdgcn_global_load_lds((const unsigned*)g, (unsigned*)l, 16, 0, 0);
}
__device__ __forceinline__ f32x4 mfma16(bf16x8 a, bf16x8 b, f32x4 c) { return __builtin_amdgcn_mfma_f32_16x16x32_bf16(a, b, c, 0, 0, 0); }
__device__ __forceinline__ bf16x8 ld8(const bf16_t* p) { return *(const bf16x8*)p; }

template <int BM, bool A_LDS>
__device__ __forceinline__ void gemm_loop(f32x4 (&acc)[BM / 32][4], const bf16_t* a0, const bf16_t* a1, const bf16_t* b0, const bf16_t* b1,
                                          int nk, unsigned char* lds, const unsigned char* hA, int hstride) {
    constexpr int MI = BM / 32;
    constexpr int A_BYTES = A_LDS ? 0 : BM * 64, STAGE = A_BYTES + 128 * 64;
    const int tid = threadIdx.x, lane = tid & 63, wid = tid >> 6, wr = wid >> 1, wc = wid & 1, fr = lane & 15, fq = lane >> 4;
#pragma unroll
    for (int m = 0; m < MI; ++m)
#pragma unroll
        for (int n = 0; n < 4; ++n) acc[m][n] = (f32x4){0.f, 0.f, 0.f, 0.f};
    auto stage = [&](int buf, int kt) {
        unsigned char* base = lds + buf * STAGE;
        if (!A_LDS) {
            glds16(a0 + kt * 32, base + tid * 16);
            if (BM == 128) glds16(a1 + kt * 32, base + 4096 + tid * 16);
        }
        glds16(b0 + kt * 32, base + A_BYTES + tid * 16);
        glds16(b1 + kt * 32, base + A_BYTES + 4096 + tid * 16);
    };
    stage(0, 0);
    asm volatile("s_waitcnt vmcnt(0)" ::: "memory");
    __syncthreads();
    for (int kt = 0; kt < nk; ++kt) {
        const int buf = kt & 1;
        if (kt + 1 < nk) stage(buf ^ 1, kt + 1);
        const unsigned char* base = lds + buf * STAGE;
        bf16x8 af[MI], bfr[4];
#pragma unroll
        for (int m = 0; m < MI; ++m) {
            if (A_LDS) af[m] = *(const bf16x8*)(hA + (size_t)(wr * (BM / 2) + m * 16 + fr) * hstride + (kt * 32 + fq * 8) * 2);
            else af[m] = *(const bf16x8*)(base + (wr * (BM / 2) + m * 16 + fr) * 64 + fq * 16);
        }
#pragma unroll
        for (int n = 0; n < 4; ++n) bfr[n] = *(const bf16x8*)(base + A_BYTES + (wc * 64 + n * 16 + fr) * 64 + fq * 16);
#pragma unroll
        for (int m = 0; m < MI; ++m)
#pragma unroll
            for (int n = 0; n < 4; ++n) acc[m][n] = mfma16(af[m], bfr[n], acc[m][n]);
        asm volatile("s_waitcnt vmcnt(0)" ::: "memory");
        __syncthreads();
    }
}

template <class Epi>
__device__ __forceinline__ void dense_gemm_phase(const bf16_t* A, int lda, const bf16_t* Bt, int K, int NT, Epi epi, unsigned char* smem) {
    const int tid = threadIdx.x, lane = tid & 63, wid = tid >> 6, wr = wid >> 1, wc = wid & 1, fr = lane & 15, fq = lane >> 4;
    const int ntiles = (NTOK / 128) * NT;
    for (int tile = blockIdx.x; tile < ntiles; tile += gridDim.x) {
        const int mt = tile / NT, nt = tile % NT;
        const bf16_t* a0 = A + (size_t)(mt * 128 + (tid >> 2)) * lda + (tid & 3) * 8;
        const bf16_t* a1 = a0 + (size_t)64 * lda;
        const bf16_t* b0 = Bt + (size_t)(nt * 128 + (tid >> 2)) * K + (tid & 3) * 8;
        const bf16_t* b1 = b0 + (size_t)64 * K;
        f32x4 acc[4][4];
        gemm_loop<128, false>(acc, a0, a1, b0, b1, K / 32, smem, nullptr, 0);
        epi(acc, mt, nt, wr, wc, fr, fq);
    }
}

__device__ __forceinline__ void xpose_tile(const float* src, const float* src2, int ld, int nsrc, int kind, bf16_t* dst, int K, int k0, int n0, unsigned char* smem) {
    bf16_t* T = (bf16_t*)smem;
    const int tid = threadIdx.x, nn = tid & 63, kq = tid >> 6;
    const int nd = n0 + nn;
    const float* sp = src; int ns;
    if (kind == 0) ns = nd < nsrc ? nd : -1;
    else if (kind == 1) ns = nd < 2048 ? nd : (nd < 3072 ? nd + 16 : (nd < 3088 ? nd - 1024 : -1));
    else { const int ch = nd >> 6, w = nd & 63; if (w < 32) ns = ch * 32 + w; else { ns = ch * 32 + w - 32; sp = src2; } }
#pragma unroll 4
    for (int i = 0; i < 16; ++i) { const int kk = i * 4 + kq; const float v = ns >= 0 ? sp[(size_t)(k0 + kk) * ld + ns] : 0.f; T[nn * 66 + kk] = f2bf(v); }
    __syncthreads();
    {
        const int n = tid >> 2, ks = (tid & 3) * 16;
        unsigned v[8];
#pragma unroll
        for (int q = 0; q < 8; ++q) v[q] = *(const unsigned*)(T + n * 66 + ks + q * 2);
        uint4* d = (uint4*)(dst + (size_t)(n0 + n) * K + k0 + ks);
        d[0] = make_uint4(v[0], v[1], v[2], v[3]); d[1] = make_uint4(v[4], v[5], v[6], v[7]);
    }
    __syncthreads();
}
__device__ __forceinline__ void convert_moe_tile(const Params& p, int L, int it, unsigned char* smem) {
    const int e = it / 192, r = it % 192;
    unsigned char* eb = p.ws + W_MOE + (size_t)e * MOE_E_BYTES;
    if (r < 128) {
        const int kt = r >> 3, ntile = r & 7;
        const float* sg = p.in[15] + (size_t)(L * 16 + e) * 1024 * 256, *su = p.in[16] + (size_t)(L * 16 + e) * 1024 * 256;
        xpose_tile(sg, su, 256, 256, 2, (bf16_t*)eb, 1024, kt * 64, ntile * 64, smem);
    } else {
        const int r2 = r - 128, kt = r2 >> 4, ntile = r2 & 15;
        const float* sd = p.in[17] + (size_t)(L * 16 + e) * 256 * 1024;
        xpose_tile(sd, nullptr, 1024, 1024, 0, (bf16_t*)(eb + (size_t)512 * 1024 * 2), 256, kt * 64, ntile * 64, smem);
    }
}
__device__ __forceinline__ void phase_prologue(const Params& p, unsigned char* smem) {
    const int tid = threadIdx.x;
    unsigned char* ws = p.ws;
    constexpr int J0 = 16 * 50, J1 = 256, J2 = 16 * 42, J3 = 256, J4 = 128, J5 = 128, J6 = 4, J7 = 4, J8 = 3072, J9 = 8192, J10 = 256, J11 = 64, J12 = 32;
    constexpr int TOTAL = J0 + J1 + J2 + J3 + J4 + J5 + J6 + J7 + J8 + J9 + J10 + J11 + J12;
    for (int item = blockIdx.x; item < TOTAL; item += gridDim.x) {
        int it = item;
        if (it < J0) { xpose_tile(p.in[1], nullptr, 3088, 3088, 1, (bf16_t*)(ws + W_GI), 1024, (it / 50) * 64, (it % 50) * 64, smem); continue; } it -= J0;
        if (it < J1) { xpose_tile(p.in[5], nullptr, 1024, 1024, 0, (bf16_t*)(ws + W_GO), 1024, (it / 16) * 64, (it % 16) * 64, smem); continue; } it -= J1;
        if (it < J2) { xpose_tile(p.in[6], nullptr, 2608, 2608, 0, (bf16_t*)(ws + W_NI), 1024, (it / 42) * 64, (it % 42) * 64, smem); continue; } it -= J2;
        if (it < J3) { xpose_tile(p.in[12], nullptr, 1024, 1024, 0, (bf16_t*)(ws + W_NO), 1024, (it / 16) * 64, (it % 16) * 64, smem); continue; } it -= J3;
        if (it < J4) { xpose_tile(p.in[7], nullptr, 256, 256, 0, (bf16_t*)(ws + W_CK1), 2048, (it / 4) * 64, (it % 4) * 64, smem); continue; } it -= J4;
        if (it < J5) { xpose_tile(p.in[9], nullptr, 256, 256, 0, (bf16_t*)(ws + W_CV1), 2048, (it / 4) * 64, (it % 4) * 64, smem); continue; } it -= J5;
        if (it < J6) { xpose_tile(p.in[8], nullptr, 64, 64, 0, (bf16_t*)(ws + W_CK2), 256, it * 64, 0, smem); continue; } it -= J6;
        if (it < J7) { xpose_tile(p.in[10], nullptr, 64, 64, 0, (bf16_t*)(ws + W_CV2), 256, it * 64, 0, smem); continue; } it -= J7;
        if (it < J8) { convert_moe_tile(p, 0, it, smem); continue; } it -= J8;
        if (it < J9) {
            const size_t e0 = (size_t)it * 2048 + tid * 8;
            const float4 v0 = *(const float4*)(p.in[0] + e0), v1 = *(const float4*)(p.in[0] + e0 + 4);
            *(uint4*)((bf16_t*)(ws + WS_B) + e0) = make_uint4(pack2(v0.x, v0.y), pack2(v0.z, v0.w), pack2(v1.x, v1.y), pack2(v1.z, v1.w));
            continue;
        } it -= J9;
        if (it < J10) {
            const int idx = it * 256 + tid, pos = idx >> 3, i = idx & 7;
            const float inv = powf(500000.0f, -(float)i * 0.125f);
            const float ang = (float)pos * inv;
            float sn, cs; sincosf(ang, &sn, &cs);
            ((float2*)(ws + WS_ROPE))[idx] = make_float2(cs, sn);
            continue;
        } it -= J10;
        if (it < J11) {
            const int idx = it * 256 + tid, e = idx >> 10, c = idx & 1023;
            ((float*)(ws + WS_WRT))[idx] = p.in[13][c * 16 + e];
            continue;
        } it -= J11;
        {
            const int which = it >> 4, hc = it & 15, ks = tid >> 4, cc = tid & 15, h = hc * 16 + cc;
            const float* w1 = p.in[which ? 9 : 7]; const float* pe = p.in[11];
            float s = 0.f;
            for (int kk = ks * 128; kk < ks * 128 + 128; ++kk) s += pe[kk] * w1[(size_t)kk * 256 + h];
            float* red = (float*)smem;
            red[tid] = s;
            __syncthreads();
            if (tid < 16) { float t = 0.f; for (int q = 0; q < 16; ++q) t += red[q * 16 + tid]; ((float*)(ws + WS_BIASC))[which * 256 + hc * 16 + tid] = t; }
            __syncthreads();
        }
    }
}

__device__ __forceinline__ void phase_gla_inproj(const Params& p, unsigned char* smem) {
    unsigned char* ws = p.ws;
    bf16_t* QK = (bf16_t*)(ws + C_QK); bf16_t* VT = (bf16_t*)(ws + C_VT); bf16_t* R = (bf16_t*)(ws + C_R); float* GLOW = (float*)(ws + WS_GLOW);
    auto epi = [&](f32x4 (&acc)[4][4], int mt, int nt, int wr, int wc, int fr, int fq) {
#pragma unroll
        for (int m = 0; m < 4; ++m)
#pragma unroll
            for (int n = 0; n < 4; ++n) {
                const int r0 = mt * 128 + wr * 64 + m * 16 + fq * 4;
                const int c = nt * 128 + wc * 64 + n * 16 + fr;
                if (nt < 8) {
                    const float sc = nt < 4 ? 0.08838834764831845f : 1.f;
#pragma unroll
                    for (int j = 0; j < 4; ++j) QK[(size_t)(r0 + j) * 1024 + c] = f2bf(acc[m][n][j] * sc);
                } else if (nt < 16) {
                    const int vcol = c - 1024, chunk = r0 >> 6, t = r0 & 63;
                    *(uint2*)(VT + ((size_t)chunk * 1024 + vcol) * 64 + t) = make_uint2(pack2(acc[m][n][0], acc[m][n][1]), pack2(acc[m][n][2], acc[m][n][3]));
                } else if (nt < 24) {
#pragma unroll
                    for (int j = 0; j < 4; ++j) R[(size_t)(r0 + j) * 1024 + (c - 2048)] = f2bf(acc[m][n][j]);
                } else {
                    if (wc == 0 && n == 0) {
#pragma unroll
                        for (int j = 0; j < 4; ++j) GLOW[(size_t)(r0 + j) * 16 + fr] = acc[m][n][j];
                    }
                }
            }
    };
    dense_gemm_phase((const bf16_t*)(ws + WS_B), 1024, (const bf16_t*)(ws + W_GI), 1024, 25, epi, smem);
}

struct GlaGate { float w[16]; float bias; };
__device__ __forceinline__ float gla_loga(const GlaGate& gg, const float* gr) {
    float z = gg.bias;
#pragma unroll
    for (int r = 0; r < 16; ++r) z += gr[r] * gg.w[r];
    return logsig_f(z) * (1.f / 16.f);
}
__device__ __forceinline__ void gla_prepare(const Params& p, int tok0, int h, GlaGate& gg, float* sGL, float* sTot, float& off, float& blast) {
    const int tid = threadIdx.x, d = tid & 127, half = tid >> 7;
    const float* GLOW = (const float*)(p.ws + WS_GLOW);
    for (int i = tid; i < 1024; i += 256) sGL[i] = GLOW[(size_t)tok0 * 16 + i];
#pragma unroll
    for (int r = 0; r < 16; ++r) gg.w[r] = p.in[2][r * 512 + h * 128 + d];
    gg.bias = p.in[3][h * 128 + d];
    __syncthreads();
    float run = 0.f;
#pragma unroll 4
    for (int i = 0; i < 32; ++i) run += gla_loga(gg, sGL + (half * 32 + i) * 16);
    sTot[half * 128 + d] = run;
    __syncthreads();
    const float t0 = sTot[d], t1 = sTot[128 + d];
    off = half ? t0 : 0.f;
    blast = t0 + t1;
}

__device__ __forceinline__ void phase_gla_kv(const Params& p, unsigned char* smem) {
    unsigned char* ws = p.ws;
    const bf16_t* QK = (const bf16_t*)(ws + C_QK); const bf16_t* VT = (const bf16_t*)(ws + C_VT);
    bf16_t* KV = (bf16_t*)(ws + WS_D); float* DEC = (float*)(ws + WS_DEC);
    float* sGL = (float*)smem; float* sTot = sGL + 1024;
    bf16_t* sKD = (bf16_t*)(sTot + 256);
    const int tid = threadIdx.x, lane = tid & 63, wid = tid >> 6, fr = lane & 15, fq = lane >> 4, d = tid & 127, half = tid >> 7;
    for (int item = blockIdx.x; item < 1024; item += gridDim.x) {
        const int c = item >> 2, h = item & 3, tok0 = c * 64;
        GlaGate gg; float off, blast;
        gla_prepare(p, tok0, h, gg, sGL, sTot, off, blast);
        {
            float run = off;
#pragma unroll 2
            for (int i = 0; i < 32; i += 2) {
                const int t = half * 32 + i;
                run += gla_loga(gg, sGL + t * 16);
                const float k0 = bf2f(QK[(size_t)(tok0 + t) * 1024 + 512 + h * 128 + d]) * __expf(blast - run);
                run += gla_loga(gg, sGL + (t + 1) * 16);
                const float k1 = bf2f(QK[(size_t)(tok0 + t + 1) * 1024 + 512 + h * 128 + d]) * __expf(blast - run);
                *(unsigned*)(sKD + d * 72 + t) = pack2(k0, k1);
            }
            if (half == 1) DEC[(size_t)item * 128 + d] = __expf(blast);
        }
        __syncthreads();
        bf16x8 af[4][2];
#pragma unroll
        for (int m = 0; m < 4; ++m)
#pragma unroll
            for (int kk = 0; kk < 2; ++kk) af[m][kk] = ld8(VT + ((size_t)c * 1024 + h * 256 + wid * 64 + m * 16 + fr) * 64 + kk * 32 + fq * 8);
#pragma unroll 1
        for (int nh = 0; nh < 2; ++nh) {
            f32x4 acc[4][4];
#pragma unroll
            for (int m = 0; m < 4; ++m)
#pragma unroll
                for (int n = 0; n < 4; ++n) acc[m][n] = (f32x4){0.f, 0.f, 0.f, 0.f};
#pragma unroll
            for (int kk = 0; kk < 2; ++kk) {
                bf16x8 bfr[4];
#pragma unroll
                for (int n = 0; n < 4; ++n) bfr[n] = *(const bf16x8*)(sKD + (nh * 64 + n * 16 + fr) * 72 + kk * 32 + fq * 8);
#pragma unroll
                for (int m = 0; m < 4; ++m)
#pragma unroll
                    for (int n = 0; n < 4; ++n) acc[m][n] = mfma16(af[m][kk], bfr[n], acc[m][n]);
            }
#pragma unroll
            for (int m = 0; m < 4; ++m)
#pragma unroll
                for (int n = 0; n < 4; ++n)
#pragma unroll
                    for (int j = 0; j < 4; ++j)
                        KV[((size_t)item * 256 + wid * 64 + m * 16 + fq * 4 + j) * 128 + nh * 64 + n * 16 + fr] = f2bf(acc[m][n][j]);
        }
        __syncthreads();
    }
}

__device__ __forceinline__ void phase_gla_scan(const Params& p, unsigned char* smem) {
    unsigned char* ws = p.ws;
    bf16_t* KV = (bf16_t*)(ws + WS_D); const float* DEC = (const float*)(ws + WS_DEC);
    const int nthreads = gridDim.x * 256;
    for (int gid = blockIdx.x * 256 + threadIdx.x; gid < 65536; gid += nthreads) {
        const int bh = gid >> 13, v = (gid >> 5) & 255, dq = gid & 31, b = bh >> 2, h = bh & 3;
        float s0 = 0.f, s1 = 0.f, s2 = 0.f, s3 = 0.f;
        for (int n0 = 0; n0 < 128; n0 += 8) {
            uint2 kv[8]; float4 dc[8];
#pragma unroll
            for (int u = 0; u < 8; ++u) {
                const size_t item = (size_t)((b * 128 + n0 + u) * 4 + h);
                kv[u] = *(const uint2*)(KV + (item * 256 + v) * 128 + dq * 4);
                dc[u] = *(const float4*)(DEC + item * 128 + dq * 4);
            }
#pragma unroll
            for (int u = 0; u < 8; ++u) {
                const size_t item = (size_t)((b * 128 + n0 + u) * 4 + h);
                *(uint2*)(KV + (item * 256 + v) * 128 + dq * 4) = make_uint2(pack2(s0, s1), pack2(s2, s3));
                s0 = dc[u].x * s0 + __uint_as_float(kv[u].x << 16);
                s1 = dc[u].y * s1 + __uint_as_float(kv[u].x & 0xFFFF0000u);
                s2 = dc[u].z * s2 + __uint_as_float(kv[u].y << 16);
                s3 = dc[u].w * s3 + __uint_as_float(kv[u].y & 0xFFFF0000u);
            }
        }
    }
}

__device__ __forceinline__ void phase_gla_out(const Params& p, unsigned char* smem) {
    unsigned char* ws = p.ws;
    const bf16_t* QK = (const bf16_t*)(ws + C_QK); const bf16_t* VT = (const bf16_t*)(ws + C_VT); const bf16_t* R = (const bf16_t*)(ws + C_R);
    const bf16_t* ST = (const bf16_t*)(ws + WS_D); bf16_t* OG = (bf16_t*)(ws + WS_B);
    float* sGL = (float*)smem; float* sTot = sGL + 1024; float* sSS = sTot + 256;
    bf16_t* sQD = (bf16_t*)(sSS + 256);
    bf16_t* sKD = sQD + 64 * 136;
    bf16_t* sP = sKD + 64 * 136;
    const int tid = threadIdx.x, lane = tid & 63, wid = tid >> 6, fr = lane & 15, fq = lane >> 4, d = tid & 127, half = tid >> 7;
    for (int item = blockIdx.x; item < 1024; item += gridDim.x) {
        const int c = item >> 2, h = item & 3, tok0 = c * 64;
        {
            GlaGate gg; float off, blast;
            gla_prepare(p, tok0, h, gg, sGL, sTot, off, blast);
            float run = off;
#pragma unroll 2
            for (int i = 0; i < 32; ++i) {
                const int t = half * 32 + i;
                run += gla_loga(gg, sGL + t * 16);
                const float qv = bf2f(QK[(size_t)(tok0 + t) * 1024 + h * 128 + d]);
                const float kv = bf2f(QK[(size_t)(tok0 + t) * 1024 + 512 + h * 128 + d]);
                sQD[t * 136 + d] = f2bf(qv * __expf(run));
                sKD[t * 136 + d] = f2bf(kv * __expf(-run));
            }
        }
        __syncthreads();
        {
            f32x4 sc[4];
#pragma unroll
            for (int n = 0; n < 4; ++n) sc[n] = (f32x4){0.f, 0.f, 0.f, 0.f};
#pragma unroll
            for (int kk = 0; kk < 4; ++kk) {
                const bf16x8 a = *(const bf16x8*)(sQD + (wid * 16 + fr) * 136 + kk * 32 + fq * 8);
#pragma unroll
                for (int n = 0; n < 4; ++n) { const bf16x8 bb = *(const bf16x8*)(sKD + (n * 16 + fr) * 136 + kk * 32 + fq * 8); sc[n] = mfma16(a, bb, sc[n]); }
            }
#pragma unroll
            for (int n = 0; n < 4; ++n)
#pragma unroll
                for (int j = 0; j < 4; ++j) {
                    const int i = wid * 16 + fq * 4 + j, jj = n * 16 + fr;
                    sP[i * 72 + jj] = f2bf(jj <= i ? sc[n][j] : 0.f);
                }
        }
        __syncthreads();
        f32x4 acc[4][4];
#pragma unroll
        for (int m = 0; m < 4; ++m)
#pragma unroll
            for (int n = 0; n < 4; ++n) acc[m][n] = (f32x4){0.f, 0.f, 0.f, 0.f};
#pragma unroll
        for (int kk = 0; kk < 2; ++kk) {
            bf16x8 af[4], bfr[4];
#pragma unroll
            for (int m = 0; m < 4; ++m) af[m] = *(const bf16x8*)(sP + (m * 16 + fr) * 72 + kk * 32 + fq * 8);
#pragma unroll
            for (int n = 0; n < 4; ++n) bfr[n] = ld8(VT + ((size_t)c * 1024 + h * 256 + wid * 64 + n * 16 + fr) * 64 + kk * 32 + fq * 8);
#pragma unroll
            for (int m = 0; m < 4; ++m)
#pragma unroll
                for (int n = 0; n < 4; ++n) acc[m][n] = mfma16(af[m], bfr[n], acc[m][n]);
        }
#pragma unroll
        for (int kk = 0; kk < 4; ++kk) {
            bf16x8 af[4], bfr[4];
#pragma unroll
            for (int m = 0; m < 4; ++m) af[m] = *(const bf16x8*)(sQD + (m * 16 + fr) * 136 + kk * 32 + fq * 8);
#pragma unroll
            for (int n = 0; n < 4; ++n) bfr[n] = ld8(ST + ((size_t)item * 256 + wid * 64 + n * 16 + fr) * 128 + kk * 32 + fq * 8);
#pragma unroll
            for (int m = 0; m < 4; ++m)
#pragma unroll
                for (int n = 0; n < 4; ++n) acc[m][n] = mfma16(af[m], bfr[n], acc[m][n]);
        }
#pragma unroll
        for (int m = 0; m < 4; ++m)
#pragma unroll
            for (int j = 0; j < 4; ++j) {
                float s = 0.f;
#pragma unroll
                for (int n = 0; n < 4; ++n) s += acc[m][n][j] * acc[m][n][j];
                s = rsum16(s);
                if (fr == 0) sSS[wid * 64 + m * 16 + fq * 4 + j] = s;
            }
        __syncthreads();
#pragma unroll
        for (int m = 0; m < 4; ++m)
#pragma unroll
            for (int j = 0; j < 4; ++j) {
                const int i = m * 16 + fq * 4 + j;
                const float tot = sSS[i] + sSS[64 + i] + sSS[128 + i] + sSS[192 + i];
                const float rs = rsqrtf(tot * (1.f / 256.f) + LN_EPS);
#pragma unroll
                for (int n = 0; n < 4; ++n) {
                    const int v = wid * 64 + n * 16 + fr;
                    const float rr = bf2f(R[(size_t)(tok0 + i) * 1024 + h * 256 + v]);
                    OG[(size_t)(tok0 + i) * 1024 + h * 256 + v] = f2bf(acc[m][n][j] * rs * p.in[4][v] * silu_f(rr));
                }
            }
        __syncthreads();
    }
}

__device__ __forceinline__ void phase_outproj(const Params& p, const bf16_t* Wt, const float* res, unsigned char* smem) {
    unsigned char* ws = p.ws;
    float* Y = (float*)(ws + WS_C);
    auto epi = [&](f32x4 (&acc)[4][4], int mt, int nt, int wr, int wc, int fr, int fq) {
#pragma unroll
        for (int m = 0; m < 4; ++m)
#pragma unroll
            for (int n = 0; n < 4; ++n)
#pragma unroll
                for (int j = 0; j < 4; ++j) {
                    const size_t idx = (size_t)(mt * 128 + wr * 64 + m * 16 + fq * 4 + j) * 1024 + nt * 128 + wc * 64 + n * 16 + fr;
                    Y[idx] = DN_ALPHA * res[idx] + acc[m][n][j];
                }
    };
    dense_gemm_phase((const bf16_t*)(ws + WS_B), 1024, Wt, 1024, 8, epi, smem);
}

__device__ __forceinline__ void phase_ln_router(const Params& p, int layer, unsigned char* smem) {
    unsigned char* ws = p.ws;
    float* Y = (float*)(ws + WS_C); bf16_t* XB = (bf16_t*)(ws + WS_B);
    const float* lg = p.in[18] + (layer * 2 + 0) * 1024; const float* lb = p.in[19] + (layer * 2 + 0) * 1024;
    const float* brt = p.in[14];
    float* PW = (float*)(ws + WS_PW); int* LIST = (int*)(ws + WS_LIST); unsigned* gcnt = (unsigned*)(ws + WS_CNT) + layer * 16;
    float* WR = (float*)smem;
    int* sE = (int*)(smem + 65536);
    int* lcnt = sE + 64; int* lbase = lcnt + 16; int* lpos = lbase + 16;
    const int tid = threadIdx.x, lane = tid & 63, wid = tid >> 6;
    for (int i = tid; i < 4096; i += 256) ((float4*)WR)[i] = ((const float4*)(ws + WS_WRT))[i];
    __syncthreads();
    for (int grp = blockIdx.x; grp < 512; grp += gridDim.x) {
        if (tid < 16) lcnt[tid] = 0;
        for (int ti = 0; ti < 8; ++ti) {
            const int tok = grp * 32 + wid * 8 + ti;
            float4 v[4];
#pragma unroll
            for (int i = 0; i < 4; ++i) v[i] = *(const float4*)(Y + (size_t)tok * 1024 + i * 256 + lane * 4);
            float s = 0.f;
#pragma unroll
            for (int i = 0; i < 4; ++i) s += (v[i].x + v[i].y) + (v[i].z + v[i].w);
            const float mu = wsum64(s) * (1.f / 1024.f);
            float q = 0.f;
#pragma unroll
            for (int i = 0; i < 4; ++i) { const float a = v[i].x - mu, b = v[i].y - mu, c = v[i].z - mu, d = v[i].w - mu; q += (a * a + b * b) + (c * c + d * d); }
            const float rstd = rsqrtf(wsum64(q) * (1.f / 1024.f) + LN_EPS);
#pragma unroll
            for (int i = 0; i < 4; ++i) {
                const float4 g4 = *(const float4*)(lg + i * 256 + lane * 4), b4 = *(const float4*)(lb + i * 256 + lane * 4);
                v[i].x = (v[i].x - mu) * rstd * g4.x + b4.x; v[i].y = (v[i].y - mu) * rstd * g4.y + b4.y;
                v[i].z = (v[i].z - mu) * rstd * g4.z + b4.z; v[i].w = (v[i].w - mu) * rstd * g4.w + b4.w;
                *(float4*)(Y + (size_t)tok * 1024 + i * 256 + lane * 4) = v[i];
                *(uint2*)(XB + (size_t)tok * 1024 + i * 256 + lane * 4) = make_uint2(pack2(v[i].x, v[i].y), pack2(v[i].z, v[i].w));
            }
            float lgt[16];
#pragma unroll
            for (int e = 0; e < 16; ++e) {
                float a = 0.f;
#pragma unroll
                for (int i = 0; i < 4; ++i) { const float4 w = *(const float4*)(WR + e * 1024 + i * 256 + lane * 4); a += v[i].x * w.x + v[i].y * w.y + v[i].z * w.z + v[i].w * w.w; }
                lgt[e] = wsum64(a);
            }
            float sg[16], bz[16];
#pragma unroll
            for (int e = 0; e < 16; ++e) { sg[e] = sigmoid_f(lgt[e]); bz[e] = sg[e] + brt[e]; }
            float gs[4];
#pragma unroll
            for (int g = 0; g < 4; ++g) {
                const float a = bz[4 * g], b = bz[4 * g + 1], c = bz[4 * g + 2], d = bz[4 * g + 3];
                const float mab = fmaxf(a, b), nab = fminf(a, b), mcd = fmaxf(c, d), ncd = fminf(c, d);
                gs[g] = fmaxf(mab, mcd) + fmaxf(fminf(mab, mcd), fmaxf(nab, ncd));
            }
            int grpi = 0; float gbest = gs[0];
#pragma unroll
            for (int g = 1; g < 4; ++g) if (gs[g] > gbest) { gbest = gs[g]; grpi = g; }
            float bv[4], sv[4];
#pragma unroll
            for (int k = 0; k < 4; ++k) {
                bv[k] = grpi == 0 ? bz[k] : (grpi == 1 ? bz[4 + k] : (grpi == 2 ? bz[8 + k] : bz[12 + k]));
                sv[k] = grpi == 0 ? sg[k] : (grpi == 1 ? sg[4 + k] : (grpi == 2 ? sg[8 + k] : sg[12 + k]));
            }
            int i1 = 0; float b1 = bv[0];
#pragma unroll
            for (int k = 1; k < 4; ++k) if (bv[k] > b1) { b1 = bv[k]; i1 = k; }
            int i2 = -1; float b2 = -3.0e38f;
#pragma unroll
            for (int k = 0; k < 4; ++k) if (k != i1 && (i2 < 0 || bv[k] > b2)) { b2 = bv[k]; i2 = k; }
            float w0 = i1 == 0 ? sv[0] : (i1 == 1 ? sv[1] : (i1 == 2 ? sv[2] : sv[3]));
            float w1 = i2 == 0 ? sv[0] : (i2 == 1 ? sv[1] : (i2 == 2 ? sv[2] : sv[3]));
            const float wsum = w0 + w1; w0 /= wsum; w1 /= wsum;
            if (lane == 0) {
                PW[(size_t)tok * 2] = w0; PW[(size_t)tok * 2 + 1] = w1;
                sE[(wid * 8 + ti) * 2] = grpi * 4 + i1; sE[(wid * 8 + ti) * 2 + 1] = grpi * 4 + i2;
            }
        }
        __syncthreads();
        int myE = 0;
        if (tid < 64) { myE = sE[tid]; lpos[tid] = atomicAdd(&lcnt[myE], 1); }
        __syncthreads();
        if (tid < 16) lbase[tid] = lcnt[tid] > 0 ? (int)atomicAdd(&gcnt[tid], (unsigned)lcnt[tid]) : 0;
        __syncthreads();
        if (tid < 64) LIST[(size_t)myE * 16384 + lbase[myE] + lpos[tid]] = grp * 64 + tid;
        __syncthreads();
    }
}

__device__ __forceinline__ void phase_moe(const Params& p, int layer, unsigned char* smem) {
    unsigned char* ws = p.ws;
    const bf16_t* XB = (const bf16_t*)(ws + WS_B); bf16_t* F = (bf16_t*)(ws + WS_D);
    const float* PW = (const float*)(ws + WS_PW); const int* LIST = (const int*)(ws + WS_LIST); const unsigned* gcnt = (const unsigned*)(ws + WS_CNT) + layer * 16;
    unsigned char* stg = smem;
    bf16_t* sH = (bf16_t*)(smem + 24576);
    int* sPair = (int*)(smem + 24576 + 64 * 264 * 2);
    float* sW = (float*)(sPair + 64);
    int* sTs = (int*)(sW + 64);
    const int tid = threadIdx.x, lane = tid & 63, wid = tid >> 6, wr = wid >> 1, wc = wid & 1, fr = lane & 15, fq = lane >> 4;
    if (tid == 0) { int a = 0; for (int e = 0; e < 16; ++e) { sTs[e] = a; a += ((int)gcnt[e] + 63) >> 6; } sTs[16] = a; }
    __syncthreads();
    const int T = sTs[16];
    for (int tile = blockIdx.x; tile < T; tile += gridDim.x) {
        int e = 0;
        for (int q = 1; q < 16; ++q) if (tile >= sTs[q]) e = q;
        const int cnt = (int)gcnt[e], rt = tile - sTs[e];
        if (tid < 64) {
            const int idx = rt * 64 + tid, ok = idx < cnt;
            const int pair = LIST[(size_t)e * 16384 + (ok ? idx : cnt - 1)];
            sPair[tid] = ok ? pair : -1; sW[tid] = PW[pair];
        }
        const int ridx = min(rt * 64 + (tid >> 2), cnt - 1);
        const int rpair = LIST[(size_t)e * 16384 + ridx];
        const bf16_t* a0 = XB + (size_t)(rpair >> 1) * 1024 + (tid & 3) * 8;
        const bf16_t* WGU = (const bf16_t*)(ws + W_MOE + (size_t)e * MOE_E_BYTES);
        const bf16_t* WDN = WGU + (size_t)512 * 1024;
        __syncthreads();
        for (int nt = 0; nt < 4; ++nt) {
            const bf16_t* b0 = WGU + (size_t)(nt * 128 + (tid >> 2)) * 1024 + (tid & 3) * 8;
            f32x4 acc[2][4];
            gemm_loop<64, false>(acc, a0, nullptr, b0, b0 + (size_t)64 * 1024, 32, stg, nullptr, 0);
#pragma unroll
            for (int m = 0; m < 2; ++m)
#pragma unroll
                for (int n = 0; n < 2; ++n)
#pragma unroll
                    for (int j = 0; j < 4; ++j) {
                        const int r = wr * 32 + m * 16 + fq * 4 + j, f = (nt * 2 + wc) * 32 + n * 16 + fr;
                        sH[r * 264 + f] = f2bf(silu_f(acc[m][n][j]) * acc[m][n + 2][j] * sW[r]);
                    }
        }
        __syncthreads();
        for (int nt = 0; nt < 8; ++nt) {
            const bf16_t* b0 = WDN + (size_t)(nt * 128 + (tid >> 2)) * 256 + (tid & 3) * 8;
            f32x4 acc[2][4];
            gemm_loop<64, true>(acc, nullptr, nullptr, b0, b0 + (size_t)64 * 256, 8, stg, (const unsigned char*)sH, 528);
#pragma unroll
            for (int m = 0; m < 2; ++m)
#pragma unroll
                for (int j = 0; j < 4; ++j) {
                    const int r = wr * 32 + m * 16 + fq * 4 + j, pair = sPair[r];
                    if (pair >= 0) {
#pragma unroll
                        for (int n = 0; n < 4; ++n) F[(size_t)pair * 1024 + nt * 128 + wc * 64 + n * 16 + fr] = f2bf(acc[m][n][j]);
                    }
                }
        }
        __syncthreads();
    }
}

__device__ __forceinline__ void phase_ln2(const Params& p, int layer, bool final_out, unsigned char* smem) {
    unsigned char* ws = p.ws;
    const float* X1 = (const float*)(ws + WS_C); const bf16_t* F = (const bf16_t*)(ws + WS_D);
    float* X2 = final_out ? p.out : (float*)(ws + WS_D); bf16_t* XB = (bf16_t*)(ws + WS_B);
    const float* lg = p.in[18] + (layer * 2 + 1) * 1024; const float* lb = p.in[19] + (layer * 2 + 1) * 1024;
    const int lane = threadIdx.x & 63, nw = gridDim.x * 4;
    for (int tok = blockIdx.x * 4 + (threadIdx.x >> 6); tok < NTOK; tok += nw) {
        float4 v[4];
#pragma unroll
        for (int i = 0; i < 4; ++i) {
            const int c = i * 256 + lane * 4;
            const float4 x = *(const float4*)(X1 + (size_t)tok * 1024 + c);
            const uint2 f0 = *(const uint2*)(F + (size_t)(tok * 2) * 1024 + c), f1 = *(const uint2*)(F + (size_t)(tok * 2 + 1) * 1024 + c);
            v[i].x = DN_ALPHA * x.x + (__uint_as_float(f0.x << 16) + __uint_as_float(f1.x << 16));
            v[i].y = DN_ALPHA * x.y + (__uint_as_float(f0.x & 0xFFFF0000u) + __uint_as_float(f1.x & 0xFFFF0000u));
            v[i].z = DN_ALPHA * x.z + (__uint_as_float(f0.y << 16) + __uint_as_float(f1.y << 16));
            v[i].w = DN_ALPHA * x.w + (__uint_as_float(f0.y & 0xFFFF0000u) + __uint_as_float(f1.y & 0xFFFF0000u));
        }
        float s = 0.f;
#pragma unroll
        for (int i = 0; i < 4; ++i) s += (v[i].x + v[i].y) + (v[i].z + v[i].w);
        const float mu = wsum64(s) * (1.f / 1024.f);
        float q = 0.f;
#pragma unroll
        for (int i = 0; i < 4; ++i) { const float a = v[i].x - mu, b = v[i].y - mu, c = v[i].z - mu, d = v[i].w - mu; q += (a * a + b * b) + (c * c + d * d); }
        const float rstd = rsqrtf(wsum64(q) * (1.f / 1024.f) + LN_EPS);
#pragma unroll
        for (int i = 0; i < 4; ++i) {
            const int c = i * 256 + lane * 4;
            const float4 g4 = *(const float4*)(lg + c), b4 = *(const float4*)(lb + c);
            float4 o;
            o.x = (v[i].x - mu) * rstd * g4.x + b4.x; o.y = (v[i].y - mu) * rstd * g4.y + b4.y;
            o.z = (v[i].z - mu) * rstd * g4.z + b4.z; o.w = (v[i].w - mu) * rstd * g4.w + b4.w;
            *(float4*)(X2 + (size_t)tok * 1024 + c) = o;
            if (!final_out) *(uint2*)(XB + (size_t)tok * 1024 + c) = make_uint2(pack2(o.x, o.y), pack2(o.z, o.w));
        }
    }
    if (!final_out) {
        for (int it = blockIdx.x; it < 3072; it += gridDim.x) convert_moe_tile(p, layer + 1, it, smem);
    }
}

__device__ __forceinline__ void phase_nsa_inproj(const Params& p, unsigned char* smem) {
    unsigned char* ws = p.ws;
    bf16_t* QN = (bf16_t*)(ws + C_QN); float* GT = (float*)(ws + WS_GT);
    const float2* ROPE = (const float2*)(ws + WS_ROPE);
    auto epi = [&](f32x4 (&acc)[4][4], int mt, int nt, int wr, int wc, int fr, int fq) {
#pragma unroll
        for (int m = 0; m < 4; ++m) {
            const int r0 = mt * 128 + wr * 64 + m * 16 + fq * 4;
            const int b = r0 >> 13, s0 = r0 & 8191;
#pragma unroll
            for (int n = 0; n < 4; ++n) {
                const int cw = wc * 64 + n * 16 + fr;
                float v[4];
#pragma unroll
                for (int j = 0; j < 4; ++j) v[j] = acc[m][n][j];
                const int kind = nt < 8 ? 0 : (nt < 20 ? 1 + ((nt - 8) >> 1) : 7);
                if (n == 0 && (kind == 0 || kind == 3 || kind == 5)) {
#pragma unroll
                    for (int j = 0; j < 4; ++j) {
                        const float pv = __shfl_xor(v[j], 8);
                        const float2 cs = ROPE[(size_t)(s0 + j) * 8 + (fr & 7)];
                        v[j] = fr < 8 ? v[j] * cs.x - pv * cs.y : v[j] * cs.x + pv * cs.y;
                    }
                }
                if (kind == 0) {
#pragma unroll
                    for (int j = 0; j < 4; ++j) QN[(size_t)(r0 + j) * 1024 + nt * 128 + cw] = f2bf(v[j] * 0.125f);
                } else if (kind == 7) {
                    if (cw < 48) {
#pragma unroll
                        for (int j = 0; j < 4; ++j) GT[(size_t)(r0 + j) * 48 + cw] = sigmoid_f(v[j]);
                    }
                } else {
                    const int g = ((nt - 8) & 1) * 2 + wc, dd = n * 16 + fr, bg = b * 4 + g;
                    bf16_t* base = (bf16_t*)(ws + C_KC + (size_t)(kind - 1) * 8 * MiB) + (size_t)bg * 8192 * 64;
                    if (kind == 4 || kind == 6) {
                        *(uint2*)(base + (size_t)dd * 8192 + s0) = make_uint2(pack2(v[0], v[1]), pack2(v[2], v[3]));
                    } else {
#pragma unroll
                        for (int j = 0; j < 4; ++j) base[(size_t)(s0 + j) * 64 + dd] = f2bf(v[j]);
                    }
                }
            }
        }
    };
    dense_gemm_phase((const bf16_t*)(ws + WS_B), 1024, (const bf16_t*)(ws + W_NI), 1024, 21, epi, smem);
}

__device__ __forceinline__ void phase_nsa_compress(const Params& p, unsigned char* smem) {
    unsigned char* ws = p.ws;
    unsigned char* stg = smem;
    bf16_t* sH = (bf16_t*)(smem + 24576);
    const float2* ROPE = (const float2*)(ws + WS_ROPE);
    const int tid = threadIdx.x, lane = tid & 63, wid = tid >> 6, wr = wid >> 1, wc = wid & 1, fr = lane & 15, fq = lane >> 4;
    for (int item = blockIdx.x; item < 128; item += gridDim.x) {
        const int which = item >> 6, bg = (item >> 3) & 7, mt = item & 7;
        const bf16_t* src = (const bf16_t*)(ws + (which ? C_VC : C_KC)) + (size_t)bg * 8192 * 64;
        const bf16_t* W1 = (const bf16_t*)(ws + (which ? W_CV1 : W_CK1));
        const bf16_t* W2 = (const bf16_t*)(ws + (which ? W_CV2 : W_CK2));
        const float* bias = (const float*)(ws + WS_BIASC) + which * 256;
        const int jrow = min(mt * 64 + (tid >> 2), 510);
        const bf16_t* a0 = src + (size_t)jrow * 1024 + (tid & 3) * 8;
        for (int nt = 0; nt < 2; ++nt) {
            const bf16_t* b0 = W1 + (size_t)(nt * 128 + (tid >> 2)) * 2048 + (tid & 3) * 8;
            f32x4 acc[2][4];
            gemm_loop<64, false>(acc, a0, nullptr, b0, b0 + (size_t)64 * 2048, 64, stg, nullptr, 0);
#pragma unroll
            for (int m = 0; m < 2; ++m)
#pragma unroll
                for (int n = 0; n < 4; ++n)
#pragma unroll
                    for (int j = 0; j < 4; ++j) {
                        const int r = wr * 32 + m * 16 + fq * 4 + j, cc = nt * 128 + wc * 64 + n * 16 + fr;
                        sH[r * 264 + cc] = f2bf(silu_f(acc[m][n][j] + bias[cc]));
                    }
        }
        __syncthreads();
        f32x4 o[4];
#pragma unroll
        for (int n = 0; n < 4; ++n) o[n] = (f32x4){0.f, 0.f, 0.f, 0.f};
#pragma unroll
        for (int kk = 0; kk < 8; ++kk) {
            const bf16x8 a = *(const bf16x8*)(sH + (wid * 16 + fr) * 264 + kk * 32 + fq * 8);
#pragma unroll
            for (int n = 0; n < 4; ++n) o[n] = mfma16(a, ld8(W2 + (size_t)(n * 16 + fr) * 256 + kk * 32 + fq * 8), o[n]);
        }
        const int j0 = mt * 64 + wid * 16 + fq * 4;
        if (which == 0) {
#pragma unroll
            for (int n = 0; n < 4; ++n)
#pragma unroll
                for (int j = 0; j < 4; ++j) {
                    float v = o[n][j];
                    const int jj = j0 + j;
                    if (n == 0) {
                        const float pv = __shfl_xor(v, 8);
                        const float2 cs = ROPE[(size_t)min(16 * jj + 31, 8191) * 8 + (fr & 7)];
                        v = fr < 8 ? v * cs.x - pv * cs.y : v * cs.x + pv * cs.y;
                    }
                    ((bf16_t*)(ws + WS_KCMP))[((size_t)bg * 512 + jj) * 64 + n * 16 + fr] = jj < 511 ? f2bf(v) : (bf16_t)0;
                }
        } else {
#pragma unroll
            for (int n = 0; n < 4; ++n) {
                const float v3 = (j0 + 3) < 511 ? o[n][3] : 0.f;
                *(uint2*)((bf16_t*)(ws + WS_VCMPT) + ((size_t)bg * 64 + n * 16 + fr) * 512 + j0) = make_uint2(pack2(o[n][0], o[n][1]), pack2(o[n][2], v3));
            }
        }
        __syncthreads();
    }
}

__device__ __forceinline__ void phase_nsa_attn(const Params& p, unsigned char* smem) {
    unsigned char* ws = p.ws;
    const bf16_t* QN = (const bf16_t*)(ws + C_QN);
    const bf16_t* KS = (const bf16_t*)(ws + C_KS); const bf16_t* VST = (const bf16_t*)(ws + C_VST);
    const bf16_t* KW = (const bf16_t*)(ws + C_KW); const bf16_t* VWT = (const bf16_t*)(ws + C_VWT);
    const bf16_t* KCMP = (const bf16_t*)(ws + WS_KCMP); const bf16_t* VCMPT = (const bf16_t*)(ws + WS_VCMPT);
    const float* GT = (const float*)(ws + WS_GT); bf16_t* O = (bf16_t*)(ws + WS_B);
    const int tid = threadIdx.x, lane = tid & 63, wid = tid >> 6, fr = lane & 15, fq = lane >> 4;
    float* impA = (float*)smem;
    float* impB = impA + 2048;
    int* sSel = (int*)(impB + 2048);
    bf16_t* sP = (bf16_t*)(sSel + 256) + wid * 16 * 72;
    for (int item = blockIdx.x; item < 4096; item += gridDim.x) {
        const int bg = item & 7, tile = 511 - (item >> 3);
        const int b = bg >> 2, g = bg & 3, s0 = tile * 16, t0 = s0 + wid * 4;
        for (int i = tid; i < 4096; i += 256) impA[i] = 0.f;
        __syncthreads();
        bf16x8 qa0, qa1;
        {
            const bf16_t* qp = QN + (size_t)(b * 8192 + t0 + (fr >> 2)) * 1024 + (g * 4 + (fr & 3)) * 64 + fq * 8;
            qa0 = ld8(qp); qa1 = ld8(qp + 32);
        }
        const int mytok = t0 + fq;
        const f32x4 zero4 = (f32x4){0.f, 0.f, 0.f, 0.f};
        const int NCV = s0 >> 4;
        const bf16_t* kc = KCMP + (size_t)bg * 512 * 64;
        float mc[4], lc[4];
#pragma unroll
        for (int j = 0; j < 4; ++j) { mc[j] = -1e30f; lc[j] = 0.f; }
        for (int c0 = 0; c0 < NCV; c0 += 16) {
            const bf16_t* kp = kc + (size_t)(c0 + fr) * 64 + fq * 8;
            f32x4 s = mfma16(qa0, ld8(kp), zero4); s = mfma16(qa1, ld8(kp + 32), s);
            const bool vis = (16 * (c0 + fr) + 31) <= mytok;
#pragma unroll
            for (int j = 0; j < 4; ++j) {
                const float sv = vis ? s[j] : -1e30f;
                const float mn = fmaxf(mc[j], rmax16(sv));
                const float pe = vis ? __expf(sv - mn) : 0.f;
                lc[j] = lc[j] * __expf(mc[j] - mn) + rsum16(pe);
                mc[j] = mn;
            }
        }
        float il[4];
#pragma unroll
        for (int j = 0; j < 4; ++j) il[j] = lc[j] > 0.f ? 1.f / lc[j] : 0.f;
        f32x4 oc[4];
#pragma unroll
        for (int n = 0; n < 4; ++n) oc[n] = zero4;
        for (int c0 = 0; c0 < NCV; c0 += 32) {
#pragma unroll
            for (int n = 0; n < 2; ++n) {
                const int key = c0 + n * 16 + fr;
                const bf16_t* kp = kc + (size_t)key * 64 + fq * 8;
                f32x4 s = mfma16(qa0, ld8(kp), zero4); s = mfma16(qa1, ld8(kp + 32), s);
                const bool vis = (16 * key + 31) <= mytok;
                float pg = 0.f;
#pragma unroll
                for (int j = 0; j < 4; ++j) {
                    const float pj = vis ? __expf(s[j] - mc[j]) * il[j] : 0.f;
                    pg += pj;
                    sP[(fq * 4 + j) * 72 + n * 16 + fr] = f2bf(pj);
                }
                float a = pg * ((fr & 3) == 0 ? 1.f : 2.f);
                a += __shfl_xor(a, 1); a += __shfl_xor(a, 2);
                if ((fr & 3) == 0) { impA[(wid * 4 + fq) * 128 + (key >> 2)] = a; impB[(wid * 4 + fq) * 128 + (key >> 2)] = pg; }
            }
            __builtin_amdgcn_wave_barrier();
            const bf16x8 pa = *(const bf16x8*)(sP + fr * 72 + fq * 8);
#pragma unroll
            for (int n = 0; n < 4; ++n) oc[n] = mfma16(pa, ld8(VCMPT + ((size_t)bg * 64 + n * 16 + fr) * 512 + c0 + fq * 8), oc[n]);
            __builtin_amdgcn_wave_barrier();
        }
        __syncthreads();
        for (int i = 0; i < 4; ++i) {
            const int tl = wid * 4 + i, t = t0 + i, cur = t >> 6;
            if (cur < 16) {
                if (lane < 16) sSel[tl * 16 + lane] = lane <= cur ? lane : -1;
            } else {
                float v0, v1;
                {
                    const int j0 = lane, j1 = lane + 64;
                    const float x0 = impA[tl * 128 + j0] + impB[tl * 128 + min(j0 + 1, 127)];
                    const float x1 = impA[tl * 128 + j1] + impB[tl * 128 + min(j1 + 1, 127)];
                    v0 = j0 > cur ? -3.0e38f : ((j0 == 0 || j0 == cur || j0 == cur - 1) ? 1e30f : x0);
                    v1 = j1 > cur ? -3.0e38f : ((j1 == 0 || j1 == cur || j1 == cur - 1) ? 1e30f : x1);
                }
                for (int r = 0; r < 16; ++r) {
                    float bv = v0; int bi = lane;
                    if (v1 > v0) { bv = v1; bi = lane + 64; }
#pragma unroll
                    for (int off = 1; off < 64; off <<= 1) {
                        const float ov = __shfl_xor(bv, off); const int oi = __shfl_xor(bi, off);
                        if (ov > bv || (ov == bv && oi < bi)) { bv = ov; bi = oi; }
                    }
                    if (lane == 0) sSel[tl * 16 + r] = bi;
                    if (bi == lane) v0 = -3.4e38f;
                    if (bi == lane + 64) v1 = -3.4e38f;
                }
            }
        }
        __syncthreads();
        f32x4 ow[4];
        float mw[4], lw[4];
#pragma unroll
        for (int n = 0; n < 4; ++n) ow[n] = zero4;
#pragma unroll
        for (int j = 0; j < 4; ++j) { mw[j] = -1e30f; lw[j] = 0.f; }
        {
            const int lo = max(0, t0 - 511), k0 = lo & ~31;
            for (int kc0 = k0; kc0 <= t0 + 3; kc0 += 32) {
                f32x4 s[2]; bool val[2];
#pragma unroll
                for (int n = 0; n < 2; ++n) {
                    const int key = kc0 + n * 16 + fr;
                    const bf16_t* kp = KW + ((size_t)bg * 8192 + key) * 64 + fq * 8;
                    s[n] = mfma16(qa0, ld8(kp), zero4); s[n] = mfma16(qa1, ld8(kp + 32), s[n]);
                    val[n] = key <= mytok && key + 512 > mytok;
                }
#pragma unroll
                for (int j = 0; j < 4; ++j) {
                    const float a0 = val[0] ? s[0][j] : -1e30f, a1 = val[1] ? s[1][j] : -1e30f;
                    const float mn = fmaxf(mw[j], rmax16(fmaxf(a0, a1)));
                    const float al = __expf(mw[j] - mn);
                    const float p0 = val[0] ? __expf(a0 - mn) : 0.f, p1 = val[1] ? __expf(a1 - mn) : 0.f;
                    lw[j] = lw[j] * al + rsum16(p0 + p1);
                    mw[j] = mn;
#pragma unroll
                    for (int n = 0; n < 4; ++n) ow[n][j] *= al;
                    sP[(fq * 4 + j) * 72 + fr] = f2bf(p0);
                    sP[(fq * 4 + j) * 72 + 16 + fr] = f2bf(p1);
                }
                __builtin_amdgcn_wave_barrier();
                const bf16x8 pa = *(const bf16x8*)(sP + fr * 72 + fq * 8);
#pragma unroll
                for (int n = 0; n < 4; ++n) ow[n] = mfma16(pa, ld8(VWT + ((size_t)bg * 64 + n * 16 + fr) * 8192 + kc0 + fq * 8), ow[n]);
                __builtin_amdgcn_wave_barrier();
            }
        }
        float g0[4], g1[4], g2[4];
        {
            const float* gp = GT + (size_t)(b * 8192 + mytok) * 48 + g * 12;
#pragma unroll
            for (int j = 0; j < 4; ++j) { g0[j] = gp[j * 3]; g1[j] = gp[j * 3 + 1]; g2[j] = gp[j * 3 + 2]; }
        }
        f32x4 of[4];
#pragma unroll
        for (int n = 0; n < 4; ++n)
#pragma unroll
            for (int j = 0; j < 4; ++j) of[n][j] = g0[j] * oc[n][j] + g2[j] * ow[n][j] / lw[j];
        for (int i = 0; i < 4; ++i) {
            const int t = t0 + i;
            f32x4 os[4];
            float ms[4], ls[4];
#pragma unroll
            for (int n = 0; n < 4; ++n) os[n] = zero4;
#pragma unroll
            for (int j = 0; j < 4; ++j) { ms[j] = -1e30f; ls[j] = 0.f; }
            for (int slot = 0; slot < 16; ++slot) {
                const int jb = __builtin_amdgcn_readfirstlane(sSel[(wid * 4 + i) * 16 + slot]);
                if (jb < 0) continue;
                f32x4 s[4]; bool val[4];
#pragma unroll
                for (int n = 0; n < 4; ++n) {
                    const int key = jb * 64 + n * 16 + fr;
                    const bf16_t* kp = KS + ((size_t)bg * 8192 + key) * 64 + fq * 8;
                    s[n] = mfma16(qa0, ld8(kp), zero4); s[n] = mfma16(qa1, ld8(kp + 32), s[n]);
                    val[n] = key <= t;
                }
#pragma unroll
                for (int j = 0; j < 4; ++j) {
                    float a[4];
#pragma unroll
                    for (int n = 0; n < 4; ++n) a[n] = val[n] ? s[n][j] : -1e30f;
                    const float mn = fmaxf(ms[j], rmax16(fmaxf(fmaxf(a[0], a[1]), fmaxf(a[2], a[3]))));
                    const float al = __expf(ms[j] - mn);
                    float ps = 0.f;
#pragma unroll
                    for (int n = 0; n < 4; ++n) { const float pn = val[n] ? __expf(a[n] - mn) : 0.f; ps += pn; sP[(fq * 4 + j) * 72 + n * 16 + fr] = f2bf(pn); }
                    ls[j] = ls[j] * al + rsum16(ps);
                    ms[j] = mn;
#pragma unroll
                    for (int n = 0; n < 4; ++n) os[n][j] *= al;
                }
                __builtin_amdgcn_wave_barrier();
                const bf16x8 pa0 = *(const bf16x8*)(sP + fr * 72 + fq * 8), pa1 = *(const bf16x8*)(sP + fr * 72 + 32 + fq * 8);
#pragma unroll
                for (int n = 0; n < 4; ++n) {
                    const bf16_t* vp = VST + ((size_t)bg * 64 + n * 16 + fr) * 8192 + jb * 64 + fq * 8;
                    os[n] = mfma16(pa0, ld8(vp), os[n]); os[n] = mfma16(pa1, ld8(vp + 32), os[n]);
                }
                __builtin_amdgcn_wave_barrier();
            }
            if (fq == i) {
#pragma unroll
                for (int n = 0; n < 4; ++n)
#pragma unroll
                    for (int j = 0; j < 4; ++j) of[n][j] += g1[j] * os[n][j] / ls[j];
            }
        }
#pragma unroll
        for (int n = 0; n < 4; ++n)
#pragma unroll
            for (int j = 0; j < 4; ++j) O[(size_t)(b * 8192 + mytok) * 1024 + g * 256 + j * 64 + n * 16 + fr] = f2bf(of[n][j]);
        __syncthreads();
    }
}

__global__ void __launch_bounds__(256, 2) hybrid_fwd(Params p) {
    unsigned char* smem = smem_dyn;
    cg::grid_group grid = cg::this_grid();
#define RUN_PHASE(N, CALL) if (p.ph_lo <= (N) && (N) < p.ph_hi) { if ((N) > p.ph_lo) grid.sync(); CALL; }
    RUN_PHASE(0, phase_prologue(p, smem))
    RUN_PHASE(1, phase_gla_inproj(p, smem))
    RUN_PHASE(2, phase_gla_kv(p, smem))
    RUN_PHASE(3, phase_gla_scan(p, smem))
    RUN_PHASE(4, phase_gla_out(p, smem))
    RUN_PHASE(5, phase_outproj(p, (const bf16_t*)(p.ws + W_GO), p.in[0], smem))
    RUN_PHASE(6, phase_ln_router(p, 0, smem))
    RUN_PHASE(7, phase_moe(p, 0, smem))
    RUN_PHASE(8, phase_ln2(p, 0, false, smem))
    RUN_PHASE(9, phase_nsa_inproj(p, smem))
    RUN_PHASE(10, phase_nsa_compress(p, smem))
    RUN_PHASE(11, phase_nsa_attn(p, smem))
    RUN_PHASE(12, phase_outproj(p, (const bf16_t*)(p.ws + W_NO), (const float*)(p.ws + WS_D), smem))
    RUN_PHASE(13, phase_ln_router(p, 1, smem))
    RUN_PHASE(14, phase_moe(p, 1, smem))
    RUN_PHASE(15, phase_ln2(p, 1, true, smem))
}

extern "C" void kernel_launch(void* const* d_in, const int* in_sizes, int n_in, void* d_out, int out_size, void* d_ws, size_t ws_size, hipStream_t stream) {
    static int grid = 0;
    if (grid == 0) {
        if (n_in != 20 || out_size != NTOK * DM || ws_size < WS_END) {
            fprintf(stderr, "kernel_launch: unexpected problem: n_in %d out %d ws %zu (need %zu)\n", n_in, out_size, ws_size, (size_t)WS_END);
            grid = -1; return;
        }
        int dev = 0, cus = 0, per_cu = 0;
        hipGetDevice(&dev);
        hipDeviceGetAttribute(&cus, hipDeviceAttributeMultiprocessorCount, dev);
        hipFuncSetAttribute((const void*)hybrid_fwd, hipFuncAttributeMaxDynamicSharedMemorySize, LDS_BYTES);
        hipOccupancyMaxActiveBlocksPerMultiprocessor(&per_cu, (const void*)hybrid_fwd, 256, LDS_BYTES);
        if (per_cu < 1) { fprintf(stderr, "kernel_launch: occupancy query says %d blocks per CU\n", per_cu); per_cu = 1; }
        if (per_cu > 2) per_cu = 2;
        grid = cus * per_cu;
        fprintf(stderr, "kernel_launch: %d CUs x %d blocks\n", cus, per_cu);
    }
    if (grid < 0) return;
    hipMemsetAsync((unsigned char*)d_ws + WS_CTL, 0, 16 * KiB, stream);
    Params p{};
    for (int i = 0; i < 20; ++i) p.in[i] = (const float*)d_in[i];
    p.out = (float*)d_out; p.ws = (unsigned char*)d_ws;
#if MK_ONE_LAUNCH
    p.ph_lo = 0; p.ph_hi = NPHASE;
    void* args[] = {&p};
    hipError_t e = hipLaunchCooperativeKernel((const void*)hybrid_fwd, dim3(grid), dim3(256), args, LDS_BYTES, stream);
    if (e != hipSuccess) fprintf(stderr, "cooperative launch failed: %s (grid %d)\n", hipGetErrorString(e), grid);
#else
    for (int ph = 0; ph < NPHASE; ++ph) {
        p.ph_lo = ph; p.ph_hi = ph + 1;
        hipLaunchKernelGGL(hybrid_fwd, dim3(grid), dim3(256), LDS_BYTES, stream, p);
    }
#endif
}
```

```cpp
#include <hip/hip_runtime.h>
#include <hip/hip_cooperative_groups.h>
#include <cstdio>
#include <cstdint>
namespace cg = cooperative_groups;

#ifndef REP_MASK
#define REP_MASK 0
#endif
#ifndef USE_CG_FIRST
#define USE_CG_FIRST 0
#endif
#ifndef PROBE_MODE
#define PROBE_MODE 0
#endif
#ifndef MK_ONE_LAUNCH
#define MK_ONE_LAUNCH 1
#endif

typedef unsigned short bf16_t;
typedef short bf16x8 __attribute__((ext_vector_type(8)));
typedef float f32x4 __attribute__((ext_vector_type(4)));

constexpr int DM = 1024, SEQ = 8192, NTOK = 16384;
constexpr float DN_ALPHA = 1.41421356237309515f;
constexpr float LN_EPS = 1e-5f;

constexpr size_t KiB = 1024, MiB = 1024 * 1024;
constexpr size_t WS_CTL = 0;
constexpr size_t WS_CNT = 14848;
constexpr size_t WS_ROPE = 64 * KiB;
constexpr size_t WS_WRT = 576 * KiB;
constexpr size_t WS_BIASC = 640 * KiB;
constexpr size_t WS_GLOW = 1 * MiB;
constexpr size_t WS_DEC = 2 * MiB;
constexpr size_t WS_PW = 2 * MiB + 512 * KiB;
constexpr size_t WS_KCMP = 3 * MiB;
constexpr size_t WS_VCMPT = 3 * MiB + 512 * KiB;
constexpr size_t WS_LIST = 4 * MiB;
constexpr size_t WS_GT = 5 * MiB;
constexpr size_t WS_W = 8 * MiB;
constexpr size_t W_GI = WS_W;
constexpr size_t W_GO = W_GI + (size_t)3200 * 1024 * 2;
constexpr size_t W_NI = W_GO + (size_t)1024 * 1024 * 2;
constexpr size_t W_NO = W_NI + (size_t)2688 * 1024 * 2;
constexpr size_t W_CK1 = W_NO + (size_t)1024 * 1024 * 2;
constexpr size_t W_CV1 = W_CK1 + (size_t)256 * 2048 * 2;
constexpr size_t W_CK2 = W_CV1 + (size_t)256 * 2048 * 2;
constexpr size_t W_CV2 = W_CK2 + (size_t)64 * 256 * 2;
constexpr size_t W_MOE = W_CV2 + (size_t)64 * 256 * 2;
constexpr size_t MOE_E_BYTES = (size_t)(512 * 1024 + 1024 * 256) * 2;
constexpr size_t W_END = W_MOE + 16 * MOE_E_BYTES;
constexpr size_t WS_B = 50 * MiB;
constexpr size_t WS_C = 82 * MiB;
constexpr size_t WS_D = 178 * MiB;
constexpr size_t WS_END = 242 * MiB;
static_assert(W_END <= WS_B, "weights overflow");
constexpr size_t C_QK = WS_C;
constexpr size_t C_VT = WS_C + 32 * MiB;
constexpr size_t C_R = WS_C + 64 * MiB;
constexpr size_t C_QN = WS_C;
constexpr size_t C_KC = WS_C + 32 * MiB;
constexpr size_t C_VC = C_KC + 8 * MiB;
constexpr size_t C_KS = C_VC + 8 * MiB;
constexpr size_t C_VST = C_KS + 8 * MiB;
constexpr size_t C_KW = C_VST + 8 * MiB;
constexpr size_t C_VWT = C_KW + 8 * MiB;
constexpr size_t C_PARK = WS_C + 80 * MiB;

constexpr int LDS_BYTES = 76 * 1024 + 16;
constexpr int NPHASE = 18;

struct Params {
    const float* in[20];
    float* out;
    unsigned char* ws;
    int ph_lo, ph_hi;
};

extern __shared__ __attribute__((aligned(16))) unsigned char smem_dyn[];

__device__ __forceinline__ bf16_t f2bf(float f) {
    unsigned u = __float_as_uint(f);
    u += 0x7FFFu + ((u >> 16) & 1u);
    return (bf16_t)(u >> 16);
}
__device__ __forceinline__ float bf2f(bf16_t h) { return __uint_as_float(((unsigned)h) << 16); }
typedef __bf16 bf16v2 __attribute__((ext_vector_type(2)));
typedef float f32v2 __attribute__((ext_vector_type(2)));
__device__ __forceinline__ unsigned pack2(float lo, float hi) { const f32v2 f = {lo, hi}; return __builtin_bit_cast(unsigned, __builtin_convertvector(f, bf16v2)); }
__device__ __forceinline__ float max3f(float a, float b, float c) { return __builtin_fmaxf(__builtin_fmaxf(a, b), c); }
__device__ __forceinline__ float silu_f(float x) { return x / (1.f + __expf(-x)); }
__device__ __forceinline__ float sigmoid_f(float x) { return 1.f / (1.f + expf(-x)); }
__device__ __forceinline__ float logsig_f(float z) { return fminf(z, 0.f) - 0.6931471805599453f * __builtin_amdgcn_logf(1.f + __builtin_amdgcn_exp2f(-1.4426950408889634f * fabsf(z))); }
__device__ __forceinline__ float rmax16(float v) {
    v = fmaxf(v, __shfl_xor(v, 1)); v = fmaxf(v, __shfl_xor(v, 2)); v = fmaxf(v, __shfl_xor(v, 4)); v = fmaxf(v, __shfl_xor(v, 8)); return v;
}
__device__ __forceinline__ float rsum16(float v) {
    v += __shfl_xor(v, 1); v += __shfl_xor(v, 2); v += __shfl_xor(v, 4); v += __shfl_xor(v, 8); return v;
}
__device__ __forceinline__ float wsum64(float v) {
    v += __shfl_xor(v, 1); v += __shfl_xor(v, 2); v += __shfl_xor(v, 4); v += __shfl_xor(v, 8); v += __shfl_xor(v, 16); v += __shfl_xor(v, 32); return v;
}
__device__ __forceinline__ float fqmax(float v) {
    unsigned u = __float_as_uint(v);
    auto r = __builtin_amdgcn_permlane16_swap(u, u, false, false);
    u = __float_as_uint(fmaxf(__uint_as_float(r[0]), __uint_as_float(r[1])));
    auto s = __builtin_amdgcn_permlane32_swap(u, u, false, false);
    return fmaxf(__uint_as_float(s[0]), __uint_as_float(s[1]));
}
__device__ __forceinline__ float fqsum(float v) {
    unsigned u = __float_as_uint(v);
    auto r = __builtin_amdgcn_permlane16_swap(u, u, false, false);
    u = __float_as_uint(__uint_as_float(r[0]) + __uint_as_float(r[1]));
    auto s = __builtin_amdgcn_permlane32_swap(u, u, false, false);
    return __uint_as_float(s[0]) + __uint_as_float(s[1]);
}
__device__ __forceinline__ float sum16(const float (&e)[4][4]) {
    return (((e[0][0] + e[0][1]) + (e[0][2] + e[0][3])) + ((e[1][0] + e[1][1]) + (e[1][2] + e[1][3]))) +
           (((e[2][0] + e[2][1]) + (e[2][2] + e[2][3])) + ((e[3][0] + e[3][1]) + (e[3][2] + e[3][3])));
}
__device__ __forceinline__ int opaque(int x) { asm volatile("" : "+v"(x)); return x; }
__device__ __forceinline__ void glds16(const void* g, void* l) {
    __builtin_amdgcn_global_load_lds((const unsigned*)g, (unsigned*)l, 16, 0, 0);
}
__device__ __forceinline__ f32x4 mfma16(bf16x8 a, bf16x8 b, f32x4 c) { return __builtin_amdgcn_mfma_f32_16x16x32_bf16(a, b, c, 0, 0, 0); }
__device__ __forceinline__ bf16x8 ld8(const bf16_t* p) { return *(const bf16x8*)p; }


#define XB_TMO      128
#define XB_XCNT(j)  (256  + 64 * (j))
#define XB_XSUB(j)  (1280 + 64 * (j))
#define XB_XGEN(j)  (2304 + 64 * (j))
#define XB_TOP      3328
#define XB_TOPGEN   3392
#define XCD_BAR_WORDS 3456
#define XB_SPIN_CAP (1u << 18)
#define LAS __attribute__((address_space(3)))
__device__ __forceinline__ unsigned xb_ld(unsigned* p)              { return __hip_atomic_load(p, __ATOMIC_RELAXED, __HIP_MEMORY_SCOPE_AGENT); }
__device__ __forceinline__ unsigned xb_add(unsigned* p, unsigned v) { return __hip_atomic_fetch_add(p, v, __ATOMIC_RELAXED, __HIP_MEMORY_SCOPE_AGENT); }
__device__ __forceinline__ unsigned xb_xcc_id() { return (unsigned)__builtin_amdgcn_s_getreg((3 << 11) | 20) & 0xFu; }
#define XB_SPIN(cond, bar) do { unsigned _sp = 0; while (cond) { __builtin_amdgcn_s_sleep(1); \
    if ((++_sp & 255u) == 0u) { if (xb_ld(&(bar)[XB_TMO])) break; if (_sp > XB_SPIN_CAP) { atomicAdd(&(bar)[XB_TMO], 1u); break; } } } } while (0)
struct XcdBarrier { unsigned* bar; unsigned x; volatile LAS unsigned* st; };
__device__ __forceinline__ XcdBarrier xcd_barrier_post(unsigned* bar, volatile LAS unsigned* st) {
    XcdBarrier b; b.bar = bar; b.x = xb_xcc_id(); b.st = st;
    if (threadIdx.x == 0) (void)xb_add(&bar[XB_XCNT(b.x)], 1u);
    return b;
}
__device__ __forceinline__ void xcd_barrier_complete(unsigned* bar, unsigned x, unsigned& nloc, unsigned& nx) {
    const unsigned G = gridDim.x * gridDim.y * gridDim.z;
    unsigned sum, cnt, mine, sp = 0u;
    for (;;) {
        sum = 0u; cnt = 0u; mine = 0u;
#pragma unroll
        for (unsigned j = 0; j < 16; ++j) { const unsigned c = xb_ld(&bar[XB_XCNT(j)]); sum += c; cnt += (c > 0u) ? 1u : 0u; mine = (j == x) ? c : mine; }
        if (sum == G) break;
        __builtin_amdgcn_s_sleep(1);
        if ((++sp & 255u) == 0u) { if (xb_ld(&bar[XB_TMO])) break; if (sp > XB_SPIN_CAP) { atomicAdd(&bar[XB_TMO], 1u); break; } }
    }
    nloc = mine > 0u ? mine : 1u; nx = cnt > 0u ? cnt : 1u;
}
__device__ __forceinline__ void xcd_barrier(const XcdBarrier& b) {
    asm volatile("s_waitcnt vmcnt(0)" ::: "memory");
    __syncthreads();
    if (threadIdx.x == 0) {
        unsigned* bar = b.bar;
        __builtin_amdgcn_s_waitcnt(0);
        unsigned nloc = b.st[0], nx = b.st[1];
        if (nloc == 0u) { xcd_barrier_complete(bar, b.x, nloc, nx); b.st[0] = nloc; b.st[1] = nx; }
        const unsigned old = xb_add(&bar[XB_XSUB(b.x)], 1u);
        const unsigned gen = old / nloc;
        if (old + 1u == (gen + 1u) * nloc) {
            __builtin_amdgcn_fence(__ATOMIC_RELEASE, "agent");
            asm volatile("s_waitcnt vmcnt(0)" ::: "memory");
            const unsigned og = xb_add(&bar[XB_TOP], 1u);
            const unsigned tg = og / nx;
            if (og + 1u == (tg + 1u) * nx) xb_add(&bar[XB_TOPGEN], 1u);
            else XB_SPIN(xb_ld(&bar[XB_TOPGEN]) == tg, bar);
            __builtin_amdgcn_fence(__ATOMIC_ACQUIRE, "agent");
            xb_add(&bar[XB_XGEN(b.x)], 1u);
            asm volatile("s_waitcnt vmcnt(0)" ::: "memory");
        } else {
            XB_SPIN(xb_ld(&bar[XB_XGEN(b.x)]) == gen, bar);
            __builtin_amdgcn_fence(__ATOMIC_ACQUIRE, "agent");
            asm volatile("s_waitcnt vmcnt(0)" ::: "memory");
        }
    }
    __syncthreads();
}

template <int BM, bool A_LDS, int NS = 4, bool SWAP = false>
__device__ __forceinline__ void gemm_loop(f32x4 (&acc)[BM / 32][4], const bf16_t* a0, const bf16_t* a1, const bf16_t* b0, const bf16_t* b1,
                                          int nk, unsigned char* lds, const unsigned char* hA, int hstride) {
    constexpr int MI = BM / 32;
    constexpr int A_BYTES = A_LDS ? 0 : BM * 64, STAGE = A_BYTES + 128 * 64;
    constexpr int G = (A_LDS ? 0 : BM / 64) + 2;
    static_assert(!(BM == 256 && NS != 3), "256-row tiles: 3 stages of 24 KiB");
    const int tid = threadIdx.x, lane = tid & 63, wid = tid >> 6, wr = wid >> 1, wc = wid & 1, fr = lane & 15, fq = lane >> 4;
#pragma unroll
    for (int m = 0; m < MI; ++m)
#pragma unroll
        for (int n = 0; n < 4; ++n) acc[m][n] = (f32x4){0.f, 0.f, 0.f, 0.f};
    const int srow = tid >> 2, lcol = ((tid & 3) ^ (((srow >> 3) & 1) << 1)) * 8 - (tid & 3) * 8;
    auto stage = [&](int slot, int kt) {
        unsigned char* base = lds + slot * STAGE;
        if (!A_LDS) {
            glds16(a0 + kt * 32 + lcol, base + tid * 16);
            if (BM >= 128) glds16(a1 + kt * 32 + lcol, base + 4096 + tid * 16);
            if (BM == 256) {
                glds16(a0 + 2 * (a1 - a0) + kt * 32 + lcol, base + 8192 + tid * 16);
                glds16(a0 + 3 * (a1 - a0) + kt * 32 + lcol, base + 12288 + tid * 16);
            }
        }
        glds16(b0 + kt * 32 + lcol, base + A_BYTES + tid * 16);
        glds16(b1 + kt * 32 + lcol, base + A_BYTES + 4096 + tid * 16);
    };
    asm volatile("s_waitcnt lgkmcnt(0)" ::: "memory");
    __builtin_amdgcn_s_barrier();
    stage(0, 0);
    if (nk > 1) stage(1, 1);
    if (NS == 4 && nk > 2) stage(2, 2);
    const int rsw = (((fr >> 3) & 1) << 1);
    for (int kt = 0; kt < nk; ++kt) {
        const int ahead = nk - 1 - kt;
        if (NS == 4 && ahead >= 2) { if (G == 4) asm volatile("s_waitcnt vmcnt(8)" ::: "memory"); else if (G == 3) asm volatile("s_waitcnt vmcnt(6)" ::: "memory"); else asm volatile("s_waitcnt vmcnt(4)" ::: "memory"); }
        else if (ahead >= 1) { if (G == 6) asm volatile("s_waitcnt vmcnt(6)" ::: "memory"); else if (G == 4) asm volatile("s_waitcnt vmcnt(4)" ::: "memory"); else if (G == 3) asm volatile("s_waitcnt vmcnt(3)" ::: "memory"); else asm volatile("s_waitcnt vmcnt(2)" ::: "memory"); }
        else asm volatile("s_waitcnt vmcnt(0)" ::: "memory");
        asm volatile("s_waitcnt lgkmcnt(0)" ::: "memory");
        __builtin_amdgcn_s_barrier();
        asm volatile("" ::: "memory");
        if (kt + NS - 1 < nk) stage((kt + NS - 1) % NS, kt + NS - 1);
        const unsigned char* base = lds + (kt % NS) * STAGE;
        bf16x8 af[MI], bfr[4];
#pragma unroll
        for (int m = 0; m < MI; ++m) {
            if (A_LDS) af[m] = *(const bf16x8*)(hA + (size_t)(wr * (BM / 2) + m * 16 + fr) * hstride + (kt * 32 + fq * 8) * 2);
            else af[m] = *(const bf16x8*)(base + (wr * (BM / 2) + m * 16 + fr) * 64 + ((fq ^ rsw) << 4));
        }
#pragma unroll
        for (int n = 0; n < 4; ++n) bfr[n] = *(const bf16x8*)(base + A_BYTES + (wc * 64 + n * 16 + fr) * 64 + ((fq ^ rsw) << 4));
#pragma unroll
        for (int m = 0; m < MI; ++m)
#pragma unroll
            for (int n = 0; n < 4; ++n) acc[m][n] = SWAP ? mfma16(bfr[n], af[m], acc[m][n]) : mfma16(af[m], bfr[n], acc[m][n]);
    }
}

constexpr int GBM = 256, GMI = GBM / 32;
template <bool SWAP = false, class Epi>
__device__ __forceinline__ void dense_gemm_phase(const bf16_t* A, int lda, const bf16_t* Bt, int K, int NT, Epi epi, unsigned char* smem) {
    const int tid = threadIdx.x, lane = tid & 63, wid = tid >> 6, wr = wid >> 1, wc = wid & 1, fr = lane & 15, fq = lane >> 4;
    const int ntiles = (NTOK / GBM) * NT;
    for (int tile = blockIdx.x; tile < ntiles; tile += gridDim.x) {
        const int xcd = tile & 7, tidx = tile >> 3;
        const int mt = (tidx / NT) * 8 + xcd, nt = tidx % NT;
        const bf16_t* a0 = A + (size_t)(mt * GBM + (tid >> 2)) * lda + (tid & 3) * 8;
        const bf16_t* a1 = a0 + (size_t)64 * lda;
        const bf16_t* b0 = Bt + (size_t)(nt * 128 + (tid >> 2)) * K + (tid & 3) * 8;
        const bf16_t* b1 = b0 + (size_t)64 * K;
        f32x4 acc[GMI][4];
        gemm_loop<GBM, false, 3, SWAP>(acc, a0, a1, b0, b1, K / 32, smem, nullptr, 0);
        epi(acc, mt * GBM + wr * (GBM / 2), nt, wc, fr, fq);
    }
}

__device__ __forceinline__ void xpose_tile(const float* src, const float* src2, int ld, int nsrc, int kind, bf16_t* dst, int ndst, int K, int k0, int n0, unsigned char* smem) {
    bf16_t* T = (bf16_t*)smem;
    const int tid = threadIdx.x, nq = tid & 15, kb = tid >> 4;
    float4 v[2][4];
#pragma unroll
    for (int hh = 0; hh < 2; ++hh) {
        const int nd = n0 + hh * 64 + nq * 4;
        const float* sp = src; int ns;
        if (kind == 0) ns = nd < nsrc ? nd : -1;
        else if (kind == 1) ns = nd < 2048 ? nd : (nd < 3072 ? nd + 16 : (nd < 3088 ? nd - 1024 : -1));
        else { const int ch = nd >> 6, w = nd & 63; if (w < 32) ns = ch * 32 + w; else { ns = ch * 32 + w - 32; sp = src2; } }
#pragma unroll
        for (int i = 0; i < 4; ++i) v[hh][i] = ns >= 0 ? *(const float4*)(sp + (size_t)(k0 + kb + 16 * i) * ld + ns) : make_float4(0.f, 0.f, 0.f, 0.f);
    }
#pragma unroll
    for (int hh = 0; hh < 2; ++hh)
#pragma unroll
        for (int i = 0; i < 4; ++i) {
            const int kk = kb + 16 * i, r = hh * 64 + nq * 4;
            T[(r + 0) * 66 + kk] = f2bf(v[hh][i].x); T[(r + 1) * 66 + kk] = f2bf(v[hh][i].y);
            T[(r + 2) * 66 + kk] = f2bf(v[hh][i].z); T[(r + 3) * 66 + kk] = f2bf(v[hh][i].w);
        }
    __syncthreads();
#pragma unroll
    for (int hh = 0; hh < 2; ++hh) {
        const int n = hh * 64 + (tid >> 2), ks = (tid & 3) * 16;
        if (n0 + n < ndst) {
            unsigned w[8];
#pragma unroll
            for (int q = 0; q < 8; ++q) w[q] = *(const unsigned*)(T + n * 66 + ks + q * 2);
            uint4* d = (uint4*)(dst + (size_t)(n0 + n) * K + k0 + ks);
            d[0] = make_uint4(w[0], w[1], w[2], w[3]); d[1] = make_uint4(w[4], w[5], w[6], w[7]);
        }
    }
    __syncthreads();
}
__device__ __forceinline__ void convert_moe_tile(const Params& p, int L, int it, unsigned char* smem) {
    const int e = it / 96, r = it % 96;
    unsigned char* eb = p.ws + W_MOE + (size_t)e * MOE_E_BYTES;
    if (r < 64) {
        const int kt = r >> 2, ntile = r & 3;
        const float* sg = p.in[15] + (size_t)(L * 16 + e) * 1024 * 256, *su = p.in[16] + (size_t)(L * 16 + e) * 1024 * 256;
        xpose_tile(sg, su, 256, 256, 2, (bf16_t*)eb, 512, 1024, kt * 64, ntile * 128, smem);
    } else {
        const int r2 = r - 64, kt = r2 >> 3, ntile = r2 & 7;
        const float* sd = p.in[17] + (size_t)(L * 16 + e) * 256 * 1024;
        xpose_tile(sd, nullptr, 1024, 1024, 0, (bf16_t*)(eb + (size_t)512 * 1024 * 2), 1024, 256, kt * 64, ntile * 128, smem);
    }
}
__device__ __forceinline__ void phase_prologue(const Params& p, unsigned char* smem) {
    const int tid = threadIdx.x;
    unsigned char* ws = p.ws;
    constexpr int J0 = 16 * 25, J1 = 128, J2 = 16 * 21, J3 = 128, J4 = 64, J5 = 64, J6 = 4, J7 = 4, J8 = 1536, J9 = 2048, J10 = 256, J11 = 64, J12 = 32;
    constexpr int TOTAL = J0 + J1 + J2 + J3 + J4 + J5 + J6 + J7 + J8 + J9 + J10 + J11 + J12;
    for (int item = blockIdx.x; item < TOTAL; item += gridDim.x) {
        int it = item;
        if (it < J12) {
            const int which = it >> 4, hc = it & 15, ks = tid >> 4, cc = tid & 15, h = hc * 16 + cc;
            const float* w1 = p.in[which ? 9 : 7]; const float* pe = p.in[11];
            float s = 0.f;
            for (int kk = ks * 128; kk < ks * 128 + 128; ++kk) s += pe[kk] * w1[(size_t)kk * 256 + h];
            float* red = (float*)smem;
            red[tid] = s;
            __syncthreads();
            if (tid < 16) { float t = 0.f; for (int q = 0; q < 16; ++q) t += red[q * 16 + tid]; ((float*)(ws + WS_BIASC))[which * 256 + hc * 16 + tid] = t; }
            __syncthreads();
            continue;
        } it -= J12;
        if (it < J10) {
            const int idx = it * 256 + tid, pos = idx >> 3, i = idx & 7;
            const float inv = powf(500000.0f, -(float)i * 0.125f);
            const float ang = (float)pos * inv;
            float sn, cs; sincosf(ang, &sn, &cs);
            ((float2*)(ws + WS_ROPE))[idx] = make_float2(cs, sn);
            continue;
        } it -= J10;
        if (it < J11) {
            const int idx = it * 256 + tid, e = idx >> 10, c = idx & 1023;
            ((float*)(ws + WS_WRT))[idx] = p.in[13][c * 16 + e];
            continue;
        } it -= J11;
        if (it < J0) { xpose_tile(p.in[1], nullptr, 3088, 3088, 1, (bf16_t*)(ws + W_GI), 3200, 1024, (it / 25) * 64, (it % 25) * 128, smem); continue; } it -= J0;
        if (it < J1) { xpose_tile(p.in[5], nullptr, 1024, 1024, 0, (bf16_t*)(ws + W_GO), 1024, 1024, (it / 8) * 64, (it % 8) * 128, smem); continue; } it -= J1;
        if (it < J2) { xpose_tile(p.in[6], nullptr, 2608, 2608, 0, (bf16_t*)(ws + W_NI), 2688, 1024, (it / 21) * 64, (it % 21) * 128, smem); continue; } it -= J2;
        if (it < J3) { xpose_tile(p.in[12], nullptr, 1024, 1024, 0, (bf16_t*)(ws + W_NO), 1024, 1024, (it / 8) * 64, (it % 8) * 128, smem); continue; } it -= J3;
        if (it < J4) { xpose_tile(p.in[7], nullptr, 256, 256, 0, (bf16_t*)(ws + W_CK1), 256, 2048, (it / 2) * 64, (it % 2) * 128, smem); continue; } it -= J4;
        if (it < J5) { xpose_tile(p.in[9], nullptr, 256, 256, 0, (bf16_t*)(ws + W_CV1), 256, 2048, (it / 2) * 64, (it % 2) * 128, smem); continue; } it -= J5;
        if (it < J6) { xpose_tile(p.in[8], nullptr, 64, 64, 0, (bf16_t*)(ws + W_CK2), 64, 256, it * 64, 0, smem); continue; } it -= J6;
        if (it < J7) { xpose_tile(p.in[10], nullptr, 64, 64, 0, (bf16_t*)(ws + W_CV2), 64, 256, it * 64, 0, smem); continue; } it -= J7;
        if (it < J8) { convert_moe_tile(p, 0, it, smem); continue; } it -= J8;
        if (it < J9) {
            float4 v[8];
#pragma unroll
            for (int u = 0; u < 4; ++u) { const size_t e0 = (size_t)it * 8192 + u * 2048 + tid * 8; v[2 * u] = *(const float4*)(p.in[0] + e0); v[2 * u + 1] = *(const float4*)(p.in[0] + e0 + 4); }
#pragma unroll
            for (int u = 0; u < 4; ++u) {
                const size_t e0 = (size_t)it * 8192 + u * 2048 + tid * 8;
                *(uint4*)((bf16_t*)(ws + WS_B) + e0) = make_uint4(pack2(v[2 * u].x, v[2 * u].y), pack2(v[2 * u].z, v[2 * u].w), pack2(v[2 * u + 1].x, v[2 * u + 1].y), pack2(v[2 * u + 1].z, v[2 * u + 1].w));
            }
            continue;
        } it -= J9;
    }
}

__device__ __forceinline__ void phase_gla_inproj(const Params& p, unsigned char* smem) {
    unsigned char* ws = p.ws;
    bf16_t* QK = (bf16_t*)(ws + C_QK); bf16_t* VT = (bf16_t*)(ws + C_VT); bf16_t* R = (bf16_t*)(ws + C_R); float* GLOW = (float*)(ws + WS_GLOW);
    auto epi = [&](f32x4 (&acc)[GMI][4], int row0, int nt, int wc, int fr, int fq) {
#pragma unroll
        for (int m = 0; m < GMI; ++m)
#pragma unroll
            for (int n = 0; n < 4; ++n) {
                const int r0 = row0 + m * 16 + fq * 4;
                const int c = nt * 128 + wc * 64 + n * 16 + fr;
                if (nt < 8) {
                    const float sc = nt < 4 ? 0.08838834764831845f : 1.f;
#pragma unroll
                    for (int j = 0; j < 4; ++j) QK[(size_t)(r0 + j) * 1024 + c] = f2bf(acc[m][n][j] * sc);
                } else if (nt < 16) {
                    const int vcol = c - 1024, chunk = r0 >> 6, t = r0 & 63;
                    *(uint2*)(VT + ((size_t)chunk * 1024 + vcol) * 64 + t) = make_uint2(pack2(acc[m][n][0], acc[m][n][1]), pack2(acc[m][n][2], acc[m][n][3]));
                } else if (nt < 24) {
#pragma unroll
                    for (int j = 0; j < 4; ++j) R[(size_t)(r0 + j) * 1024 + (c - 2048)] = f2bf(acc[m][n][j]);
                } else {
                    if (wc == 0 && n == 0) {
#pragma unroll
                        for (int j = 0; j < 4; ++j) GLOW[(size_t)(r0 + j) * 16 + fr] = acc[m][n][j];
                    }
                }
            }
    };
    dense_gemm_phase((const bf16_t*)(ws + WS_B), 1024, (const bf16_t*)(ws + W_GI), 1024, 25, epi, smem);
}

struct GlaGate { float w[16]; float bias; };
__device__ __forceinline__ float gla_loga(const GlaGate& gg, const float* gr) {
    float z = gg.bias;
#pragma unroll
    for (int r = 0; r < 16; ++r) z += gr[r] * gg.w[r];
    return logsig_f(z) * (1.f / 16.f);
}
__device__ __forceinline__ void gla_prepare(const Params& p, int tok0, int h, GlaGate& gg, float* sGL, float* sTot, float& off, float& blast) {
    const int tid = threadIdx.x, d = tid & 127, half = tid >> 7;
    const float* GLOW = (const float*)(p.ws + WS_GLOW);
    for (int i = tid; i < 1024; i += 256) sGL[i] = GLOW[(size_t)tok0 * 16 + i];
#pragma unroll
    for (int r = 0; r < 16; ++r) gg.w[r] = p.in[2][r * 512 + h * 128 + d];
    gg.bias = p.in[3][h * 128 + d];
    __syncthreads();
    float run = 0.f;
#pragma unroll 4
    for (int i = 0; i < 32; ++i) run += gla_loga(gg, sGL + (half * 32 + i) * 16);
    sTot[half * 128 + d] = run;
    __syncthreads();
    const float t0 = sTot[d], t1 = sTot[128 + d];
    off = half ? t0 : 0.f;
    blast = t0 + t1;
}

__device__ __forceinline__ void phase_gla_kv(const Params& p, unsigned char* smem) {
    unsigned char* ws = p.ws;
    const bf16_t* QK = (const bf16_t*)(ws + C_QK); const bf16_t* VT = (const bf16_t*)(ws + C_VT);
    bf16_t* KV = (bf16_t*)(ws + WS_D); float* DEC = (float*)(ws + WS_DEC);
    float* sGL = (float*)smem; float* sTot = sGL + 1024;
    bf16_t* sKD = (bf16_t*)(sTot + 256);
    bf16_t* sK = sKD + 128 * 72;
    const int tid = threadIdx.x, lane = tid & 63, wid = tid >> 6, fr = lane & 15, fq = lane >> 4, d = tid & 127, half = tid >> 7;
    for (int item = blockIdx.x; item < 1024; item += gridDim.x) {
        const int c = item >> 2, h = item & 3, tok0 = c * 64;
#pragma unroll
        for (int i = 0; i < 4; ++i) {
            const int ch = tid + i * 256, t = ch >> 4, cc = ch & 15;
            *(uint4*)(sK + t * 136 + cc * 8) = *(const uint4*)(QK + (size_t)(tok0 + t) * 1024 + 512 + h * 128 + cc * 8);
        }
        bf16x8 bf[4][2];
#pragma unroll
        for (int n = 0; n < 4; ++n)
#pragma unroll
            for (int kk = 0; kk < 2; ++kk) bf[n][kk] = ld8(VT + ((size_t)c * 1024 + h * 256 + wid * 64 + n * 16 + fr) * 64 + kk * 32 + fq * 8);
        float la[32];
        {
            const float* GLOW = (const float*)(ws + WS_GLOW);
            for (int i = tid; i < 1024; i += 256) sGL[i] = GLOW[(size_t)tok0 * 16 + i];
            GlaGate gg;
#pragma unroll
            for (int r = 0; r < 16; ++r) gg.w[r] = p.in[2][r * 512 + h * 128 + d];
            gg.bias = p.in[3][h * 128 + d];
            __syncthreads();
            float tot = 0.f;
#pragma unroll
            for (int i = 0; i < 32; ++i) { la[i] = gla_loga(gg, sGL + (half * 32 + i) * 16); tot += la[i]; }
            sTot[half * 128 + d] = tot;
            __syncthreads();
        }
        {
            const float t0 = sTot[d], t1 = sTot[128 + d], blast = t0 + t1;
            float run = half ? t0 : 0.f;
            float* BC = (float*)((bf16_t*)(ws + WS_B) + (size_t)tok0 * 1024 + h * 256) + d;
#pragma unroll
            for (int i = 0; i < 32; i += 2) {
                const int t = half * 32 + i;
                run += la[i];
                BC[(size_t)t * 512] = run;
                const float k0 = bf2f(sK[t * 136 + d]) * __expf(blast - run);
                run += la[i + 1];
                BC[(size_t)(t + 1) * 512] = run;
                const float k1 = bf2f(sK[(t + 1) * 136 + d]) * __expf(blast - run);
                *(unsigned*)(sKD + d * 72 + t) = pack2(k0, k1);
            }
            if (half == 1) DEC[(size_t)item * 128 + d] = __expf(blast);
        }
        __syncthreads();
#pragma unroll 1
        for (int dh = 0; dh < 2; ++dh) {
            f32x4 acc[4][4];
#pragma unroll
            for (int m = 0; m < 4; ++m)
#pragma unroll
                for (int n = 0; n < 4; ++n) acc[m][n] = (f32x4){0.f, 0.f, 0.f, 0.f};
#pragma unroll
            for (int kk = 0; kk < 2; ++kk) {
                bf16x8 af[4];
#pragma unroll
                for (int m = 0; m < 4; ++m) af[m] = *(const bf16x8*)(sKD + (dh * 64 + m * 16 + fr) * 72 + kk * 32 + fq * 8);
#pragma unroll
                for (int m = 0; m < 4; ++m)
#pragma unroll
                    for (int n = 0; n < 4; ++n) acc[m][n] = mfma16(af[m], bf[n][kk], acc[m][n]);
            }
#pragma unroll
            for (int m = 0; m < 4; ++m)
#pragma unroll
                for (int n = 0; n < 4; ++n)
                    *(uint2*)(KV + ((size_t)item * 256 + wid * 64 + n * 16 + fr) * 128 + dh * 64 + m * 16 + fq * 4) =
                        make_uint2(pack2(acc[m][n][0], acc[m][n][1]), pack2(acc[m][n][2], acc[m][n][3]));
        }
        __syncthreads();
    }
}

__device__ __forceinline__ void phase_gla_scan(const Params& p, unsigned char* smem) {
    unsigned char* ws = p.ws;
    bf16_t* KV = (bf16_t*)(ws + WS_D); const float* DEC = (const float*)(ws + WS_DEC);
    const int nthreads = gridDim.x * 256;
    for (int gid = blockIdx.x * 256 + threadIdx.x; gid < 65536; gid += nthreads) {
        const int bh = gid >> 13, v = (gid >> 5) & 255, dq = gid & 31, b = bh >> 2, h = bh & 3;
        float s0 = 0.f, s1 = 0.f, s2 = 0.f, s3 = 0.f;
        for (int n0 = 0; n0 < 128; n0 += 8) {
            uint2 kv[8]; float4 dc[8];
#pragma unroll
            for (int u = 0; u < 8; ++u) {
                const size_t item = (size_t)((b * 128 + n0 + u) * 4 + h);
                kv[u] = *(const uint2*)(KV + (item * 256 + v) * 128 + dq * 4);
                dc[u] = *(const float4*)(DEC + item * 128 + dq * 4);
            }
#pragma unroll
            for (int u = 0; u < 8; ++u) {
                const size_t item = (size_t)((b * 128 + n0 + u) * 4 + h);
                *(uint2*)(KV + (item * 256 + v) * 128 + dq * 4) = make_uint2(pack2(s0, s1), pack2(s2, s3));
                s0 = dc[u].x * s0 + __uint_as_float(kv[u].x << 16);
                s1 = dc[u].y * s1 + __uint_as_float(kv[u].x & 0xFFFF0000u);
                s2 = dc[u].z * s2 + __uint_as_float(kv[u].y << 16);
                s3 = dc[u].w * s3 + __uint_as_float(kv[u].y & 0xFFFF0000u);
            }
        }
    }
}

__device__ __forceinline__ void phase_gla_out(const Params& p, unsigned char* smem) {
    unsigned char* ws = p.ws;
    const bf16_t* QK = (const bf16_t*)(ws + C_QK); const bf16_t* VT = (const bf16_t*)(ws + C_VT); const bf16_t* R = (const bf16_t*)(ws + C_R);
    const bf16_t* ST = (const bf16_t*)(ws + WS_D); bf16_t* OG = (bf16_t*)(ws + WS_B);
    float* sGL = (float*)smem; float* sTot = sGL + 1024; float* sSS = sTot + 256;
    bf16_t* sQD = (bf16_t*)(sSS + 256);
    bf16_t* sKD = sQD + 64 * 136;
    bf16_t* sP = sKD + 64 * 136;
    const int tid = threadIdx.x, lane = tid & 63, wid = tid >> 6, fr = lane & 15, fq = lane >> 4, d = tid & 127, half = tid >> 7;
    for (int item = blockIdx.x; item < 1024; item += gridDim.x) {
        const int c = item >> 2, h = item & 3, tok0 = c * 64;
#pragma unroll
        for (int i = 0; i < 4; ++i) {
            const int ch = tid + i * 256, t = ch >> 4, cc = ch & 15;
            const bf16_t* src = QK + (size_t)(tok0 + t) * 1024 + h * 128 + cc * 8;
            *(uint4*)(sQD + t * 136 + cc * 8) = *(const uint4*)src;
            *(uint4*)(sKD + t * 136 + cc * 8) = *(const uint4*)(src + 512);
        }
        {
            const float* BC = (const float*)((const bf16_t*)(ws + WS_B) + (size_t)tok0 * 1024 + h * 256) + d;
            float bb[32];
#pragma unroll
            for (int i = 0; i < 32; ++i) bb[i] = BC[(size_t)(half * 32 + i) * 512];
            __syncthreads();
#pragma unroll
            for (int i = 0; i < 32; ++i) {
                const int t = half * 32 + i;
                sQD[t * 136 + d] = f2bf(bf2f(sQD[t * 136 + d]) * __expf(bb[i]));
                sKD[t * 136 + d] = f2bf(bf2f(sKD[t * 136 + d]) * __expf(-bb[i]));
            }
        }
        __syncthreads();
        {
            f32x4 sc[4];
#pragma unroll
            for (int n = 0; n < 4; ++n) sc[n] = (f32x4){0.f, 0.f, 0.f, 0.f};
#pragma unroll
            for (int kk = 0; kk < 4; ++kk) {
                const bf16x8 a = *(const bf16x8*)(sQD + (wid * 16 + fr) * 136 + kk * 32 + fq * 8);
#pragma unroll
                for (int n = 0; n < 4; ++n) { const bf16x8 bb = *(const bf16x8*)(sKD + (n * 16 + fr) * 136 + kk * 32 + fq * 8); sc[n] = mfma16(a, bb, sc[n]); }
            }
#pragma unroll
            for (int n = 0; n < 4; ++n)
#pragma unroll
                for (int j = 0; j < 4; ++j) {
                    const int i = wid * 16 + fq * 4 + j, jj = n * 16 + fr;
                    sP[i * 72 + jj] = f2bf(jj <= i ? sc[n][j] : 0.f);
                }
        }
        __syncthreads();
        f32x4 acc[4][4];
#pragma unroll
        for (int m = 0; m < 4; ++m)
#pragma unroll
            for (int n = 0; n < 4; ++n) acc[m][n] = (f32x4){0.f, 0.f, 0.f, 0.f};
#pragma unroll
        for (int kk = 0; kk < 2; ++kk) {
            bf16x8 af[4], bfr[4];
#pragma unroll
            for (int m = 0; m < 4; ++m) af[m] = ld8(VT + ((size_t)c * 1024 + h * 256 + wid * 64 + m * 16 + fr) * 64 + kk * 32 + fq * 8);
#pragma unroll
            for (int n = 0; n < 4; ++n) bfr[n] = *(const bf16x8*)(sP + (n * 16 + fr) * 72 + kk * 32 + fq * 8);
#pragma unroll
            for (int m = 0; m < 4; ++m)
#pragma unroll
                for (int n = 0; n < 4; ++n) acc[m][n] = mfma16(af[m], bfr[n], acc[m][n]);
        }
#pragma unroll
        for (int kk = 0; kk < 4; ++kk) {
            bf16x8 af[4], bfr[4];
#pragma unroll
            for (int m = 0; m < 4; ++m) af[m] = ld8(ST + ((size_t)item * 256 + wid * 64 + m * 16 + fr) * 128 + kk * 32 + fq * 8);
#pragma unroll
            for (int n = 0; n < 4; ++n) bfr[n] = *(const bf16x8*)(sQD + (n * 16 + fr) * 136 + kk * 32 + fq * 8);
#pragma unroll
            for (int m = 0; m < 4; ++m)
#pragma unroll
                for (int n = 0; n < 4; ++n) acc[m][n] = mfma16(af[m], bfr[n], acc[m][n]);
        }
#pragma unroll
        for (int n = 0; n < 4; ++n) {
            float s = 0.f;
#pragma unroll
            for (int m = 0; m < 4; ++m)
#pragma unroll
                for (int j = 0; j < 4; ++j) s += acc[m][n][j] * acc[m][n][j];
            s = fqsum(s);
            if (fq == 0) sSS[wid * 64 + n * 16 + fr] = s;
        }
        __syncthreads();
#pragma unroll
        for (int n = 0; n < 4; ++n) {
            const int i = n * 16 + fr;
            const float tot = sSS[i] + sSS[64 + i] + sSS[128 + i] + sSS[192 + i];
            const float rs = rsqrtf(tot * (1.f / 256.f) + LN_EPS);
#pragma unroll
            for (int m = 0; m < 4; ++m) {
                const int v0 = wid * 64 + m * 16 + fq * 4;
                const size_t idx = (size_t)(tok0 + i) * 1024 + h * 256 + v0;
                const uint2 rr = *(const uint2*)(R + idx);
                const float4 ng = *(const float4*)(p.in[4] + v0);
                const float o0 = acc[m][n][0] * rs * ng.x * silu_f(__uint_as_float(rr.x << 16));
                const float o1 = acc[m][n][1] * rs * ng.y * silu_f(__uint_as_float(rr.x & 0xFFFF0000u));
                const float o2 = acc[m][n][2] * rs * ng.z * silu_f(__uint_as_float(rr.y << 16));
                const float o3 = acc[m][n][3] * rs * ng.w * silu_f(__uint_as_float(rr.y & 0xFFFF0000u));
                *(uint2*)(OG + idx) = make_uint2(pack2(o0, o1), pack2(o2, o3));
            }
        }
        __syncthreads();
    }
}

__device__ __forceinline__ void phase_outproj(const Params& p, const bf16_t* Wt, const float* res, unsigned char* smem) {
    unsigned char* ws = p.ws;
    float* Y = (float*)(ws + WS_C);
    auto epi = [&](f32x4 (&acc)[GMI][4], int row0, int nt, int wc, int fr, int fq) {
#pragma unroll
        for (int m = 0; m < GMI; ++m)
#pragma unroll
            for (int n = 0; n < 4; ++n) {
                const size_t idx = (size_t)(row0 + m * 16 + fr) * 1024 + nt * 128 + wc * 64 + n * 16 + fq * 4;
                const float4 r = *(const float4*)(res + idx);
                *(float4*)(Y + idx) = make_float4(DN_ALPHA * r.x + acc[m][n][0], DN_ALPHA * r.y + acc[m][n][1], DN_ALPHA * r.z + acc[m][n][2], DN_ALPHA * r.w + acc[m][n][3]);
            }
    };
    dense_gemm_phase<true>((const bf16_t*)(ws + WS_B), 1024, Wt, 1024, 8, epi, smem);
}

__device__ __forceinline__ void phase_ln_router(const Params& p, int layer, unsigned char* smem) {
    unsigned char* ws = p.ws;
    float* Y = (float*)(ws + WS_C); bf16_t* XB = (bf16_t*)(ws + WS_B);
    const float* lg = p.in[18] + (layer * 2 + 0) * 1024; const float* lb = p.in[19] + (layer * 2 + 0) * 1024;
    const float* brt = p.in[14];
    float* PW = (float*)(ws + WS_PW); int* LIST = (int*)(ws + WS_LIST); unsigned* gcnt = (unsigned*)(ws + WS_CNT) + layer * 16;
    float* WR = (float*)smem;
    int* sE = (int*)(smem + 65536);
    int* lcnt = sE + 64; int* lbase = lcnt + 16; int* lpos = lbase + 16;
    const int tid = threadIdx.x, lane = tid & 63, wid = tid >> 6;
    for (int i = tid; i < 4096; i += 256) ((float4*)WR)[i] = ((const float4*)(ws + WS_WRT))[i];
    __syncthreads();
    for (int grp = blockIdx.x; grp < 512; grp += gridDim.x) {
        if (tid < 16) lcnt[tid] = 0;
        for (int ti = 0; ti < 8; ++ti) {
            const int tok = grp * 32 + wid * 8 + ti;
            float4 v[4];
#pragma unroll
            for (int i = 0; i < 4; ++i) v[i] = *(const float4*)(Y + (size_t)tok * 1024 + i * 256 + lane * 4);
            float s = 0.f;
#pragma unroll
            for (int i = 0; i < 4; ++i) s += (v[i].x + v[i].y) + (v[i].z + v[i].w);
            const float mu = wsum64(s) * (1.f / 1024.f);
            float q = 0.f;
#pragma unroll
            for (int i = 0; i < 4; ++i) { const float a = v[i].x - mu, b = v[i].y - mu, c = v[i].z - mu, d = v[i].w - mu; q += (a * a + b * b) + (c * c + d * d); }
            const float rstd = rsqrtf(wsum64(q) * (1.f / 1024.f) + LN_EPS);
#pragma unroll
            for (int i = 0; i < 4; ++i) {
                const float4 g4 = *(const float4*)(lg + i * 256 + lane * 4), b4 = *(const float4*)(lb + i * 256 + lane * 4);
                v[i].x = (v[i].x - mu) * rstd * g4.x + b4.x; v[i].y = (v[i].y - mu) * rstd * g4.y + b4.y;
                v[i].z = (v[i].z - mu) * rstd * g4.z + b4.z; v[i].w = (v[i].w - mu) * rstd * g4.w + b4.w;
                *(float4*)(Y + (size_t)tok * 1024 + i * 256 + lane * 4) = v[i];
                *(uint2*)(XB + (size_t)tok * 1024 + i * 256 + lane * 4) = make_uint2(pack2(v[i].x, v[i].y), pack2(v[i].z, v[i].w));
            }
            float lgt[16];
#pragma unroll
            for (int e = 0; e < 16; ++e) {
                float a = 0.f;
#pragma unroll
                for (int i = 0; i < 4; ++i) { const float4 w = *(const float4*)(WR + e * 1024 + i * 256 + lane * 4); a += v[i].x * w.x + v[i].y * w.y + v[i].z * w.z + v[i].w * w.w; }
                lgt[e] = wsum64(a);
            }
            float sg[16], bz[16];
#pragma unroll
            for (int e = 0; e < 16; ++e) { sg[e] = sigmoid_f(lgt[e]); bz[e] = sg[e] + brt[e]; }
            float gs[4];
#pragma unroll
            for (int g = 0; g < 4; ++g) {
                const float a = bz[4 * g], b = bz[4 * g + 1], c = bz[4 * g + 2], d = bz[4 * g + 3];
                const float mab = fmaxf(a, b), nab = fminf(a, b), mcd = fmaxf(c, d), ncd = fminf(c, d);
                gs[g] = fmaxf(mab, mcd) + fmaxf(fminf(mab, mcd), fmaxf(nab, ncd));
            }
            int grpi = 0; float gbest = gs[0];
#pragma unroll
            for (int g = 1; g < 4; ++g) if (gs[g] > gbest) { gbest = gs[g]; grpi = g; }
            float bv[4], sv[4];
#pragma unroll
            for (int k = 0; k < 4; ++k) {
                bv[k] = grpi == 0 ? bz[k] : (grpi == 1 ? bz[4 + k] : (grpi == 2 ? bz[8 + k] : bz[12 + k]));
                sv[k] = grpi == 0 ? sg[k] : (grpi == 1 ? sg[4 + k] : (grpi == 2 ? sg[8 + k] : sg[12 + k]));
            }
            int i1 = 0; float b1 = bv[0];
#pragma unroll
            for (int k = 1; k < 4; ++k) if (bv[k] > b1) { b1 = bv[k]; i1 = k; }
            int i2 = -1; float b2 = -3.0e38f;
#pragma unroll
            for (int k = 0; k < 4; ++k) if (k != i1 && (i2 < 0 || bv[k] > b2)) { b2 = bv[k]; i2 = k; }
            float w0 = i1 == 0 ? sv[0] : (i1 == 1 ? sv[1] : (i1 == 2 ? sv[2] : sv[3]));
            float w1 = i2 == 0 ? sv[0] : (i2 == 1 ? sv[1] : (i2 == 2 ? sv[2] : sv[3]));
            const float wsum = w0 + w1; w0 /= wsum; w1 /= wsum;
            if (lane == 0) {
                PW[(size_t)tok * 2] = w0; PW[(size_t)tok * 2 + 1] = w1;
                sE[(wid * 8 + ti) * 2] = grpi * 4 + i1; sE[(wid * 8 + ti) * 2 + 1] = grpi * 4 + i2;
            }
        }
        __syncthreads();
        int myE = 0;
        if (tid < 64) { myE = sE[tid]; lpos[tid] = atomicAdd(&lcnt[myE], 1); }
        __syncthreads();
        if (tid < 16) lbase[tid] = lcnt[tid] > 0 ? (int)atomicAdd(&gcnt[tid], (unsigned)lcnt[tid]) : 0;
        __syncthreads();
        if (tid < 64) LIST[(size_t)myE * 16384 + lbase[myE] + lpos[tid]] = grp * 64 + tid;
        __syncthreads();
    }
}

constexpr size_t C_H = WS_C + 64 * MiB;
constexpr int MBM = 128, MMI = MBM / 32;
__device__ __forceinline__ void moe_tiles(const unsigned* gcnt, int* sTs) {
    if (threadIdx.x == 0) { int a = 0; for (int e = 0; e < 16; ++e) { sTs[e] = a; a += ((int)gcnt[e] + MBM - 1) / MBM; } sTs[16] = a; }
    __syncthreads();
}
__device__ __forceinline__ void phase_moe_a(const Params& p, int layer, unsigned char* smem) {
    unsigned char* ws = p.ws;
    const bf16_t* XB = (const bf16_t*)(ws + WS_B); bf16_t* H = (bf16_t*)(ws + C_H);
    const float* PW = (const float*)(ws + WS_PW); const int* LIST = (const int*)(ws + WS_LIST); const unsigned* gcnt = (const unsigned*)(ws + WS_CNT) + layer * 16;
    unsigned char* stg = smem;
    float* sW = (float*)(smem + 65536);
    int* sTs = (int*)(sW + MBM);
    const int tid = threadIdx.x, lane = tid & 63, wid = tid >> 6, wr = wid >> 1, wc = wid & 1, fr = lane & 15, fq = lane >> 4;
    moe_tiles(gcnt, sTs);
    const int T = sTs[16];
    for (int item = blockIdx.x; item < T * 4; item += gridDim.x) {
        const int tile = item >> 2, nt = item & 3;
        int e = 0;
        for (int q = 1; q < 16; ++q) if (tile >= sTs[q]) e = q;
        const int cnt = (int)gcnt[e], rt = tile - sTs[e];
        if (tid < MBM) { const int idx = min(rt * MBM + tid, cnt - 1); sW[tid] = PW[LIST[(size_t)e * 16384 + idx]]; }
        const int p0 = LIST[(size_t)e * 16384 + min(rt * MBM + (tid >> 2), cnt - 1)];
        const int p1 = LIST[(size_t)e * 16384 + min(rt * MBM + 64 + (tid >> 2), cnt - 1)];
        const bf16_t* a0 = XB + (size_t)(p0 >> 1) * 1024 + (tid & 3) * 8;
        const bf16_t* a1 = XB + (size_t)(p1 >> 1) * 1024 + (tid & 3) * 8;
        const bf16_t* WGU = (const bf16_t*)(ws + W_MOE + (size_t)e * MOE_E_BYTES);
        const bf16_t* b0 = WGU + (size_t)(nt * 128 + (tid >> 2)) * 1024 + (tid & 3) * 8;
        f32x4 acc[MMI][4];
        gemm_loop<MBM, false>(acc, a0, a1, b0, b0 + (size_t)64 * 1024, 32, stg, nullptr, 0);
#pragma unroll
        for (int m = 0; m < MMI; ++m)
#pragma unroll
            for (int n = 0; n < 2; ++n)
#pragma unroll
                for (int j = 0; j < 4; ++j) {
                    const int r = wr * (MBM / 2) + m * 16 + fq * 4 + j, f = (nt * 2 + wc) * 32 + n * 16 + fr;
                    H[((size_t)tile * MBM + r) * 256 + f] = f2bf(silu_f(acc[m][n][j]) * acc[m][n + 2][j] * sW[r]);
                }
        __syncthreads();
    }
}
__device__ __forceinline__ void phase_moe_b(const Params& p, int layer, unsigned char* smem) {
    unsigned char* ws = p.ws;
    const bf16_t* H = (const bf16_t*)(ws + C_H); bf16_t* F = (bf16_t*)(ws + WS_D);
    const int* LIST = (const int*)(ws + WS_LIST); const unsigned* gcnt = (const unsigned*)(ws + WS_CNT) + layer * 16;
    unsigned char* stg = smem;
    int* sPair = (int*)(smem + 65536);
    int* sTs = sPair + MBM;
    const int tid = threadIdx.x, lane = tid & 63, wid = tid >> 6, wr = wid >> 1, wc = wid & 1, fr = lane & 15, fq = lane >> 4;
    moe_tiles(gcnt, sTs);
    const int T = sTs[16];
    for (int item = blockIdx.x; item < T * 8; item += gridDim.x) {
        const int tile = item >> 3, nt = item & 7;
        int e = 0;
        for (int q = 1; q < 16; ++q) if (tile >= sTs[q]) e = q;
        const int cnt = (int)gcnt[e], rt = tile - sTs[e];
        if (tid < MBM) { const int idx = rt * MBM + tid; sPair[tid] = idx < cnt ? LIST[(size_t)e * 16384 + idx] : -1; }
        const bf16_t* a0 = H + ((size_t)tile * MBM + (tid >> 2)) * 256 + (tid & 3) * 8;
        const bf16_t* WDN = (const bf16_t*)(ws + W_MOE + (size_t)e * MOE_E_BYTES) + (size_t)512 * 1024;
        const bf16_t* b0 = WDN + (size_t)(nt * 128 + (tid >> 2)) * 256 + (tid & 3) * 8;
        f32x4 acc[MMI][4];
        gemm_loop<MBM, false>(acc, a0, a0 + (size_t)64 * 256, b0, b0 + (size_t)64 * 256, 8, stg, nullptr, 0);
#pragma unroll
        for (int m = 0; m < MMI; ++m)
#pragma unroll
            for (int j = 0; j < 4; ++j) {
                const int r = wr * (MBM / 2) + m * 16 + fq * 4 + j, pair = sPair[r];
                if (pair >= 0) {
#pragma unroll
                    for (int n = 0; n < 4; ++n) F[(size_t)pair * 1024 + nt * 128 + wc * 64 + n * 16 + fr] = f2bf(acc[m][n][j]);
                }
            }
        __syncthreads();
    }
}

__device__ __forceinline__ void phase_ln2(const Params& p, int layer, bool final_out, unsigned char* smem) {
    unsigned char* ws = p.ws;
    const float* X1 = (const float*)(ws + WS_C); const bf16_t* F = (const bf16_t*)(ws + WS_D);
    float* X2 = final_out ? p.out : (float*)(ws + WS_D); bf16_t* XB = (bf16_t*)(ws + WS_B);
    const float* lg = p.in[18] + (layer * 2 + 1) * 1024; const float* lb = p.in[19] + (layer * 2 + 1) * 1024;
    const int lane = threadIdx.x & 63, nw = gridDim.x * 4;
    for (int tok = blockIdx.x * 4 + (threadIdx.x >> 6); tok < NTOK; tok += nw) {
        float4 v[4];
#pragma unroll
        for (int i = 0; i < 4; ++i) {
            const int c = i * 256 + lane * 4;
            const float4 x = *(const float4*)(X1 + (size_t)tok * 1024 + c);
            const uint2 f0 = *(const uint2*)(F + (size_t)(tok * 2) * 1024 + c), f1 = *(const uint2*)(F + (size_t)(tok * 2 + 1) * 1024 + c);
            v[i].x = DN_ALPHA * x.x + (__uint_as_float(f0.x << 16) + __uint_as_float(f1.x << 16));
            v[i].y = DN_ALPHA * x.y + (__uint_as_float(f0.x & 0xFFFF0000u) + __uint_as_float(f1.x & 0xFFFF0000u));
            v[i].z = DN_ALPHA * x.z + (__uint_as_float(f0.y << 16) + __uint_as_float(f1.y << 16));
            v[i].w = DN_ALPHA * x.w + (__uint_as_float(f0.y & 0xFFFF0000u) + __uint_as_float(f1.y & 0xFFFF0000u));
        }
        float s = 0.f;
#pragma unroll
        for (int i = 0; i < 4; ++i) s += (v[i].x + v[i].y) + (v[i].z + v[i].w);
        const float mu = wsum64(s) * (1.f / 1024.f);
        float q = 0.f;
#pragma unroll
        for (int i = 0; i < 4; ++i) { const float a = v[i].x - mu, b = v[i].y - mu, c = v[i].z - mu, d = v[i].w - mu; q += (a * a + b * b) + (c * c + d * d); }
        const float rstd = rsqrtf(wsum64(q) * (1.f / 1024.f) + LN_EPS);
#pragma unroll
        for (int i = 0; i < 4; ++i) {
            const int c = i * 256 + lane * 4;
            const float4 g4 = *(const float4*)(lg + c), b4 = *(const float4*)(lb + c);
            float4 o;
            o.x = (v[i].x - mu) * rstd * g4.x + b4.x; o.y = (v[i].y - mu) * rstd * g4.y + b4.y;
            o.z = (v[i].z - mu) * rstd * g4.z + b4.z; o.w = (v[i].w - mu) * rstd * g4.w + b4.w;
            *(float4*)(X2 + (size_t)tok * 1024 + c) = o;
            if (!final_out) *(uint2*)(XB + (size_t)tok * 1024 + c) = make_uint2(pack2(o.x, o.y), pack2(o.z, o.w));
        }
    }
    if (!final_out) {
        for (int it = blockIdx.x; it < 1536; it += gridDim.x) convert_moe_tile(p, layer + 1, it, smem);
    }
}

__device__ __forceinline__ void phase_nsa_inproj(const Params& p, unsigned char* smem) {
    unsigned char* ws = p.ws;
    bf16_t* QN = (bf16_t*)(ws + C_QN); float* GT = (float*)(ws + WS_GT);
    const float2* ROPE = (const float2*)(ws + WS_ROPE);
    auto epi = [&](f32x4 (&acc)[GMI][4], int row0, int nt, int wc, int fr, int fq) {
#pragma unroll
        for (int m = 0; m < GMI; ++m) {
            const int r0 = row0 + m * 16 + fq * 4;
            const int b = r0 >> 13, s0 = r0 & 8191;
#pragma unroll
            for (int n = 0; n < 4; ++n) {
                const int cw = wc * 64 + n * 16 + fr;
                float v[4];
#pragma unroll
                for (int j = 0; j < 4; ++j) v[j] = acc[m][n][j];
                const int kind = nt < 8 ? 0 : (nt < 20 ? 1 + ((nt - 8) >> 1) : 7);
                if (n == 0 && (kind == 0 || kind == 3 || kind == 5)) {
#pragma unroll
                    for (int j = 0; j < 4; ++j) {
                        const float pv = __shfl_xor(v[j], 8);
                        const float2 cs = ROPE[(size_t)(s0 + j) * 8 + (fr & 7)];
                        v[j] = fr < 8 ? v[j] * cs.x - pv * cs.y : v[j] * cs.x + pv * cs.y;
                    }
                }
                if (kind == 0) {
#pragma unroll
                    for (int j = 0; j < 4; ++j) QN[(size_t)(r0 + j) * 1024 + nt * 128 + cw] = f2bf(v[j] * 0.18033688011112042f);
                } else if (kind == 7) {
                    if (cw < 48) {
#pragma unroll
                        for (int j = 0; j < 4; ++j) GT[(size_t)(r0 + j) * 48 + cw] = sigmoid_f(v[j]);
                    }
                } else {
                    const int g = ((nt - 8) & 1) * 2 + wc, dd = n * 16 + fr, bg = b * 4 + g;
                    bf16_t* base = (bf16_t*)(ws + C_KC + (size_t)(kind - 1) * 8 * MiB) + (size_t)bg * 8192 * 64;
                    if (kind == 3) {
                        unsigned char* k8 = ws + C_KS + ((size_t)bg * 8192 + s0) * 64 + dd;
#pragma unroll
                        for (int j = 0; j < 4; ++j) k8[j * 64] = (unsigned char)__builtin_amdgcn_cvt_pk_fp8_f32(v[j], v[j], 0, false);
                    } else if (kind == 4) {
                        unsigned pk = __builtin_amdgcn_cvt_pk_fp8_f32(v[0], v[1], 0, false);
                        pk = __builtin_amdgcn_cvt_pk_fp8_f32(v[2], v[3], pk, true);
                        *(unsigned*)(ws + C_VST + ((size_t)bg * 64 + dd) * 8192 + s0) = pk;
                    } else if (kind == 6) {
                        *(uint2*)(base + (size_t)dd * 8192 + s0) = make_uint2(pack2(v[0], v[1]), pack2(v[2], v[3]));
                    } else {
#pragma unroll
                        for (int j = 0; j < 4; ++j) base[(size_t)(s0 + j) * 64 + dd] = f2bf(v[j]);
                    }
                }
            }
        }
    };
    dense_gemm_phase((const bf16_t*)(ws + WS_B), 1024, (const bf16_t*)(ws + W_NI), 1024, 21, epi, smem);
}

__device__ __forceinline__ void phase_nsa_compress(const Params& p, unsigned char* smem) {
    unsigned char* ws = p.ws;
    unsigned char* stg = smem;
    bf16_t* sH = (bf16_t*)(smem + 36864);
    const float2* ROPE = (const float2*)(ws + WS_ROPE);
    const int tid = threadIdx.x, lane = tid & 63, wid = tid >> 6, wr = wid >> 1, wc = wid & 1, fr = lane & 15, fq = lane >> 4;
    for (int item = blockIdx.x; item < 128; item += gridDim.x) {
        const int which = item >> 6, bg = (item >> 3) & 7, mt = item & 7;
        const bf16_t* src = (const bf16_t*)(ws + (which ? C_VC : C_KC)) + (size_t)bg * 8192 * 64;
        const bf16_t* W1 = (const bf16_t*)(ws + (which ? W_CV1 : W_CK1));
        const bf16_t* W2 = (const bf16_t*)(ws + (which ? W_CV2 : W_CK2));
        const float* bias = (const float*)(ws + WS_BIASC) + which * 256;
        const int jrow = min(mt * 64 + (tid >> 2), 510);
        const bf16_t* a0 = src + (size_t)jrow * 1024 + (tid & 3) * 8;
        for (int nt = 0; nt < 2; ++nt) {
            const bf16_t* b0 = W1 + (size_t)(nt * 128 + (tid >> 2)) * 2048 + (tid & 3) * 8;
            f32x4 acc[2][4];
            gemm_loop<64, false, 3>(acc, a0, nullptr, b0, b0 + (size_t)64 * 2048, 64, stg, nullptr, 0);
#pragma unroll
            for (int m = 0; m < 2; ++m)
#pragma unroll
                for (int n = 0; n < 4; ++n)
#pragma unroll
                    for (int j = 0; j < 4; ++j) {
                        const int r = wr * 32 + m * 16 + fq * 4 + j, cc = nt * 128 + wc * 64 + n * 16 + fr;
                        sH[r * 264 + cc] = f2bf(silu_f(acc[m][n][j] + bias[cc]));
                    }
        }
        __syncthreads();
        f32x4 o[4];
#pragma unroll
        for (int n = 0; n < 4; ++n) o[n] = (f32x4){0.f, 0.f, 0.f, 0.f};
#pragma unroll
        for (int kk = 0; kk < 8; ++kk) {
            const bf16x8 a = *(const bf16x8*)(sH + (wid * 16 + fr) * 264 + kk * 32 + fq * 8);
#pragma unroll
            for (int n = 0; n < 4; ++n) o[n] = mfma16(a, ld8(W2 + (size_t)(n * 16 + fr) * 256 + kk * 32 + fq * 8), o[n]);
        }
        const int j0 = mt * 64 + wid * 16 + fq * 4;
        if (which == 0) {
#pragma unroll
            for (int n = 0; n < 4; ++n)
#pragma unroll
                for (int j = 0; j < 4; ++j) {
                    float v = o[n][j];
                    const int jj = j0 + j;
                    if (n == 0) {
                        const float pv = __shfl_xor(v, 8);
                        const float2 cs = ROPE[(size_t)min(16 * jj + 31, 8191) * 8 + (fr & 7)];
                        v = fr < 8 ? v * cs.x - pv * cs.y : v * cs.x + pv * cs.y;
                    }
                    ((bf16_t*)(ws + WS_KCMP))[((size_t)bg * 512 + jj) * 64 + n * 16 + fr] = jj < 511 ? f2bf(v) : (bf16_t)0;
                }
        } else {
#pragma unroll
            for (int n = 0; n < 4; ++n) {
                const float v3 = (j0 + 3) < 511 ? o[n][3] : 0.f;
                *(uint2*)((bf16_t*)(ws + WS_VCMPT) + ((size_t)bg * 64 + n * 16 + fr) * 512 + j0) = make_uint2(pack2(o[n][0], o[n][1]), pack2(o[n][2], v3));
            }
        }
        __syncthreads();
    }
}

__device__ __forceinline__ void phase_nsa_attn(const Params& p, unsigned char* smem, const int mode = 7) {
    unsigned char* ws = p.ws;
    const bf16_t* QN = (const bf16_t*)(ws + C_QN);
    const bf16_t* KS = (const bf16_t*)(ws + C_KS); const bf16_t* VST = (const bf16_t*)(ws + C_VST);
    const bf16_t* KW = (const bf16_t*)(ws + C_KW); const bf16_t* VWT = (const bf16_t*)(ws + C_VWT);
    const bf16_t* KCMP = (const bf16_t*)(ws + WS_KCMP); const bf16_t* VCMPT = (const bf16_t*)(ws + WS_VCMPT);
    const float* GT = (const float*)(ws + WS_GT); bf16_t* O = (bf16_t*)(ws + WS_B);
    const int tid = threadIdx.x, lane = tid & 63, wid = tid >> 6, fr = lane & 15, fq = lane >> 4;
    unsigned* sMask = (unsigned*)smem;
    unsigned char* sList = smem + 384;
    unsigned char* sQ = smem + 512;
    unsigned char* R = smem + 8704;
    float* impA = (float*)R;
    float* impB = impA + 2048;
    unsigned char* stg = R + 16384;
    const f32x4 zero4 = (f32x4){0.f, 0.f, 0.f, 0.f};
    auto issue = [&](int buf, const bf16_t* kt, const bf16_t* vt, int vstride, bool with_v) {
        unsigned char* kb = stg + buf * 16384; unsigned char* vb = kb + 8192;
#pragma unroll
        for (int h = 0; h < 2; ++h) {
            const int row = (tid >> 3) + h * 32, lc = (tid & 7) ^ ((row >> 1) & 7);
            glds16(kt + row * 64 + lc * 8, kb + h * 4096 + tid * 16);
            if (with_v) glds16(vt + (size_t)row * vstride + lc * 8, vb + h * 4096 + tid * 16);
        }
    };
    auto ring_sync = [&](int newer) {
        if (newer == 0) asm volatile("s_waitcnt vmcnt(0) lgkmcnt(0)" ::: "memory");
        else if (newer == 2) asm volatile("s_waitcnt vmcnt(2) lgkmcnt(0)" ::: "memory");
        else if (newer == 8) asm volatile("s_waitcnt vmcnt(8) lgkmcnt(0)" ::: "memory");
        else asm volatile("s_waitcnt vmcnt(4) lgkmcnt(0)" ::: "memory");
        __builtin_amdgcn_s_barrier();
        asm volatile("" ::: "memory");
    };
    auto ldsK = [&](int buf, int mt, int c) -> bf16x8 {
        const int row = mt * 16 + fr;
        return *(const bf16x8*)(stg + buf * 16384 + row * 128 + (((c * 4 + fq) ^ ((row >> 1) & 7)) << 4));
    };
    auto ldsV = [&](int buf, int dt, int c) -> bf16x8 {
        const int row = dt * 16 + fr;
        const unsigned char* rb = stg + buf * 16384 + 8192 + row * 128 + (fq & 1) * 8;
        const int sw = (row >> 1) & 7, ch = 4 * c + (fq >> 1);
        const uint2 lo = *(const uint2*)(rb + ((ch ^ sw) << 4)), hi = *(const uint2*)(rb + (((ch + 2) ^ sw) << 4));
        union { uint4 u; bf16x8 v; } cv; cv.u = make_uint4(lo.x, lo.y, hi.x, hi.y);
        return cv.v;
    };
    for (int item = blockIdx.x; item < 4096; item += gridDim.x) {
        const int bg = item & 7, tile = 511 - (item >> 3);
        const int b = bg >> 2, g = bg & 3, s0 = tile * 16, t0 = s0 + wid * 4;
        for (int i = tid; i < 4096; i += 256) impA[i] = 0.f;
        const int mytok = t0 + (fr >> 2), myhead = fr & 3;
        bf16x8 qa0, qa1;
        {
            const bf16_t* qp = QN + (size_t)(b * 8192 + mytok) * 1024 + (g * 4 + myhead) * 64 + fq * 8;
            qa0 = ld8(qp); qa1 = ld8(qp + 32);
        }
        auto qk_tile = [&](int buf, f32x4 (&st)[4]) {
#pragma unroll
            for (int mt = 0; mt < 4; ++mt) { st[mt] = mfma16(ldsK(buf, mt, 0), qa0, zero4); st[mt] = mfma16(ldsK(buf, mt, 1), qa1, st[mt]); }
        };
        auto pv_tile = [&](int buf, const uint4 (&pb)[2], f32x4 (&o)[4]) {
#pragma unroll
            for (int c = 0; c < 2; ++c) {
                union { uint4 u; bf16x8 v; } cv; cv.u = pb[c];
#pragma unroll
                for (int dt = 0; dt < 4; ++dt) o[dt] = mfma16(ldsV(buf, dt, c), cv.v, o[dt]);
            }
        };
        auto pack_p = [&](const float (&e)[4][4], uint4 (&pb)[2]) {
            pb[0] = make_uint4(pack2(e[0][0], e[0][1]), pack2(e[0][2], e[0][3]), pack2(e[1][0], e[1][1]), pack2(e[1][2], e[1][3]));
            pb[1] = make_uint4(pack2(e[2][0], e[2][1]), pack2(e[2][2], e[2][3]), pack2(e[3][0], e[3][1]), pack2(e[3][2], e[3][3]));
        };
        auto online = [&](const f32x4 (&st)[4], const bool masked, auto key_ok, const bool col_on, float& m, float& l, f32x4 (&o)[4], uint4 (&pb)[2]) {
            float a[4][4];
#pragma unroll
            for (int mt = 0; mt < 4; ++mt)
#pragma unroll
                for (int j = 0; j < 4; ++j) a[mt][j] = (masked && !key_ok(mt, j)) ? -1e30f : st[mt][j];
            float mx = max3f(max3f(max3f(a[0][0], a[0][1], a[0][2]), max3f(a[0][3], a[1][0], a[1][1]), max3f(a[1][2], a[1][3], a[2][0])),
                             max3f(max3f(a[2][1], a[2][2], a[2][3]), max3f(a[3][0], a[3][1], a[3][2]), a[3][3]), -1e30f);
            mx = col_on ? mx : -1e30f;
            mx = fqmax(mx);
            if (__any(mx > m)) {
                const float mn = fmaxf(m, mx), al = __builtin_amdgcn_exp2f(m - mn);
                l *= al; m = mn;
#pragma unroll
                for (int dt = 0; dt < 4; ++dt) o[dt] *= al;
            }
            float e[4][4];
#pragma unroll
            for (int mt = 0; mt < 4; ++mt)
#pragma unroll
                for (int j = 0; j < 4; ++j) { const float x = __builtin_amdgcn_exp2f(a[mt][j] - m); e[mt][j] = (masked && !key_ok(mt, j)) ? 0.f : x; }
            float ps = sum16(e);
            pack_p(e, pb);
            if (!col_on) { ps = 0.f; pb[0] = make_uint4(0u, 0u, 0u, 0u); pb[1] = make_uint4(0u, 0u, 0u, 0u); }
            l += ps;
        };
        const int NCT = (mode & 1) ? ((s0 >> 4) + 63) >> 6 : 0;
        const bf16_t* kc = KCMP + (size_t)bg * 512 * 64;
        const bf16_t* vc = VCMPT + (size_t)bg * 64 * 512;
        float mc = -1e30f, lc = 0.f;
        __syncthreads();
        if (NCT > 0) issue(0, kc, vc, 512, false);
        if (NCT > 1) issue(1, kc + (size_t)64 * 64, vc + 64, 512, false);
        for (int it = 0; it < NCT; ++it) {
            ring_sync(it + 1 < NCT ? 2 : 0);
            if (it + 2 < NCT) issue((it + 2) % 3, kc + (size_t)(it + 2) * 64 * 64, vc + (it + 2) * 64, 512, false);
            f32x4 st[4];
            qk_tile(it % 3, st);
            const bool masked = (16 * (it * 64 + 63) + 31) > s0;
            auto vis = [&](int mt, int j) -> bool { return (16 * (it * 64 + mt * 16 + fq * 4 + j) + 31) <= mytok; };
            float a[4][4];
#pragma unroll
            for (int mt = 0; mt < 4; ++mt)
#pragma unroll
                for (int j = 0; j < 4; ++j) a[mt][j] = (masked && !vis(mt, j)) ? -1e30f : st[mt][j];
            float mx = max3f(max3f(max3f(a[0][0], a[0][1], a[0][2]), max3f(a[0][3], a[1][0], a[1][1]), max3f(a[1][2], a[1][3], a[2][0])),
                             max3f(max3f(a[2][1], a[2][2], a[2][3]), max3f(a[3][0], a[3][1], a[3][2]), a[3][3]), -1e30f);
            mx = fqmax(mx);
            const float mn = fmaxf(mc, mx);
            float e[4][4];
#pragma unroll
            for (int mt = 0; mt < 4; ++mt)
#pragma unroll
                for (int j = 0; j < 4; ++j) { const float x = __builtin_amdgcn_exp2f(a[mt][j] - mn); e[mt][j] = (masked && !vis(mt, j)) ? 0.f : x; }
            lc = lc * __builtin_amdgcn_exp2f(mc - mn) + sum16(e); mc = mn;
        }
        lc = fqsum(lc);
        const float il = lc > 0.f ? 1.f / lc : 0.f;
        f32x4 oc[4];
#pragma unroll
        for (int dt = 0; dt < 4; ++dt) oc[dt] = zero4;
        __syncthreads();
        if (NCT > 0) issue(0, kc, vc, 512, true);
        if (NCT > 1) issue(1, kc + (size_t)64 * 64, vc + 64, 512, true);
        for (int it = 0; it < NCT; ++it) {
            ring_sync(it + 1 < NCT ? 4 : 0);
            if (it + 2 < NCT) issue((it + 2) % 3, kc + (size_t)(it + 2) * 64 * 64, vc + (it + 2) * 64, 512, true);
            f32x4 st[4];
            qk_tile(it % 3, st);
            const bool masked = (16 * (it * 64 + 63) + 31) > s0;
            float pp[4][4];
#pragma unroll
            for (int mt = 0; mt < 4; ++mt) {
                float pg[4];
#pragma unroll
                for (int j = 0; j < 4; ++j) {
                    const bool hid = masked && (16 * (it * 64 + mt * 16 + fq * 4 + j) + 31) > mytok;
                    const float x = __builtin_amdgcn_exp2f(st[mt][j] - mc) * il;
                    const float pj = hid ? 0.f : x;
                    pp[mt][j] = pj;
                    float q4 = pj; q4 += __shfl_xor(q4, 1); q4 += __shfl_xor(q4, 2);
                    pg[j] = q4;
                }
                if (myhead == 0) {
                    const int jb = it * 16 + mt * 4 + fq;
                    impA[(wid * 4 + (fr >> 2)) * 128 + jb] = pg[0] + 2.f * (pg[1] + pg[2] + pg[3]);
                    impB[(wid * 4 + (fr >> 2)) * 128 + jb] = pg[0];
                }
            }
            uint4 pb[2];
            pack_p(pp, pb);
            pv_tile(it % 3, pb, oc);
        }
        __syncthreads();
        {
            unsigned wu0 = 0u, wu1 = 0u, wu2 = 0u, wu3 = 0u;
            for (int i = 0; i < 4; ++i) {
                const int tl = wid * 4 + i, t = t0 + i, cur = t >> 6;
                unsigned w0, w1, w2, w3;
                if (cur < 16) { w0 = (2u << cur) - 1u; w1 = 0u; w2 = 0u; w3 = 0u; }
                else {
                    const int j0 = lane, j1 = lane + 64;
                    float x0, x1;
                    if (mode & 1) {
                        x0 = impA[tl * 128 + j0] + impB[tl * 128 + min(j0 + 1, 127)];
                        x1 = impA[tl * 128 + j1] + impB[tl * 128 + min(j1 + 1, 127)];
                    } else {
                        x0 = (float)(((unsigned)t * 7u + (unsigned)j0 * 13u + (unsigned)(j0 * j0) * 5u) % 1021u);
                        x1 = (float)(((unsigned)t * 7u + (unsigned)j1 * 13u + (unsigned)(j1 * j1) * 5u) % 1021u);
                    }
                    const unsigned k0 = j0 > cur ? 0u : (((j0 == 0 || j0 == cur || j0 == cur - 1) ? 0x7F000000u : __float_as_uint(x0)) + 1u);
                    const unsigned k1 = j1 > cur ? 0u : (((j1 == 0 || j1 == cur || j1 == cur - 1) ? 0x7F000000u : __float_as_uint(x1)) + 1u);
                    unsigned T = 0u;
                    for (int bit = 31; bit >= 0; --bit) {
                        const unsigned cand = T | (1u << bit);
                        const int c = __popcll(__ballot(k0 >= cand)) + __popcll(__ballot(k1 >= cand));
                        if (c >= 16) T = cand;
                    }
                    const unsigned long long gt0 = __ballot(k0 > T), gt1 = __ballot(k1 > T), eq0 = __ballot(k0 == T), eq1 = __ballot(k1 == T);
                    const int r = 16 - __popcll(gt0) - __popcll(gt1);
                    const int rank0 = (int)__builtin_amdgcn_mbcnt_hi((unsigned)(eq0 >> 32), __builtin_amdgcn_mbcnt_lo((unsigned)eq0, 0u));
                    const int rank1 = __popcll(eq0) + (int)__builtin_amdgcn_mbcnt_hi((unsigned)(eq1 >> 32), __builtin_amdgcn_mbcnt_lo((unsigned)eq1, 0u));
                    const unsigned long long s0m = __ballot(k0 > T || (k0 == T && rank0 < r));
                    const unsigned long long s1m = __ballot(k1 > T || (k1 == T && rank1 < r));
                    w0 = (unsigned)s0m; w1 = (unsigned)(s0m >> 32); w2 = (unsigned)s1m; w3 = (unsigned)(s1m >> 32);
                }
                if (lane == 0) { sMask[tl * 4 + 0] = w0; sMask[tl * 4 + 1] = w1; sMask[tl * 4 + 2] = w2; sMask[tl * 4 + 3] = w3; }
                wu0 |= w0; wu1 |= w1; wu2 |= w2; wu3 |= w3;
            }
            if (lane == 0) { sMask[64 + wid * 4 + 0] = wu0; sMask[64 + wid * 4 + 1] = wu1; sMask[64 + wid * 4 + 2] = wu2; sMask[64 + wid * 4 + 3] = wu3; }
        }
        __syncthreads();
        f32x4 ow[4];
        float mw = -1e30f, lw = 0.f;
#pragma unroll
        for (int dt = 0; dt < 4; ++dt) ow[dt] = zero4;
        {
            const int k0 = max(0, s0 - 511) & ~63;
            const int NWT = (mode & 2) ? ((s0 + 15 - k0) >> 6) + 1 : 0;
            const bf16_t* kw = KW + ((size_t)bg * 8192 + k0) * 64;
            const bf16_t* vw = VWT + (size_t)bg * 64 * 8192 + k0;
            if (NWT > 0) issue(0, kw, vw, 8192, true);
            if (NWT > 1) issue(1, kw + (size_t)64 * 64, vw + 64, 8192, true);
            for (int it = 0; it < NWT; ++it) {
                ring_sync(it + 1 < NWT ? 4 : 0);
                if (it + 2 < NWT) issue((it + 2) % 3, kw + (size_t)(it + 2) * 64 * 64, vw + (it + 2) * 64, 8192, true);
                f32x4 st[4]; uint4 pb[2];
                qk_tile(it % 3, st);
                const int kb = k0 + it * 64;
                const bool masked = !(kb + 63 <= s0 && kb + 512 > s0 + 15);
                auto ok = [&](int mt, int j) -> bool { const int key = kb + mt * 16 + fq * 4 + j; return key <= mytok && key + 512 > mytok; };
                if (masked) online(st, true, ok, true, mw, lw, ow, pb); else online(st, false, ok, true, mw, lw, ow, pb);
                pv_tile(it % 3, pb, ow);
            }
        }
        {
            const float* gp = GT + (size_t)(b * 8192 + mytok) * 48 + g * 12 + myhead * 3;
            const float g0 = gp[0], g2 = (mode & 2) ? gp[2] / fqsum(lw) : 0.f;
#pragma unroll
            for (int dt = 0; dt < 4; ++dt) oc[dt] = oc[dt] * g0 + ow[dt] * g2;
        }
        f32x4 os[4];
        float lsel = 1.f;
#pragma unroll
        for (int dt = 0; dt < 4; ++dt) os[dt] = zero4;
        if (mode & 4) {
            float* park = (float*)(ws + C_PARK) + (size_t)blockIdx.x * 4096;
#pragma unroll
            for (int dt = 0; dt < 4; ++dt) *(f32x4*)(park + (dt * 256 + tid) * 4) = oc[dt];
            {
                auto to8 = [&](const bf16x8 q) -> uint2 {
                    float f[8];
#pragma unroll
                    for (int e = 0; e < 8; ++e) f[e] = __uint_as_float(((unsigned)(unsigned short)q[e]) << 16);
                    unsigned lo = __builtin_amdgcn_cvt_pk_fp8_f32(f[0], f[1], 0, false); lo = __builtin_amdgcn_cvt_pk_fp8_f32(f[2], f[3], lo, true);
                    unsigned hi = __builtin_amdgcn_cvt_pk_fp8_f32(f[4], f[5], 0, false); hi = __builtin_amdgcn_cvt_pk_fp8_f32(f[6], f[7], hi, true);
                    return make_uint2(lo, hi);
                };
                *(uint2*)(sQ + ((wid * 2 + 0) * 64 + lane) * 8) = to8(qa0);
                *(uint2*)(sQ + ((wid * 2 + 1) * 64 + lane) * 8) = to8(qa1);
            }
            unsigned un[4];
#pragma unroll
            for (int w = 0; w < 4; ++w) un[w] = sMask[64 + w] | sMask[68 + w] | sMask[72 + w] | sMask[76 + w];
            const int U = __popc(un[0]) + __popc(un[1]) + __popc(un[2]) + __popc(un[3]);
            if (wid == 0) {
                const unsigned lo_below = __builtin_amdgcn_mbcnt_hi(un[1], __builtin_amdgcn_mbcnt_lo(un[0], 0u));
                const unsigned hi_below = __builtin_amdgcn_mbcnt_hi(un[3], __builtin_amdgcn_mbcnt_lo(un[2], 0u));
                if ((un[lane >> 5] >> (lane & 31)) & 1u) sList[lo_below] = (unsigned char)lane;
                if ((un[2 + (lane >> 5)] >> (lane & 31)) & 1u) sList[__popc(un[0]) + __popc(un[1]) + hi_below] = (unsigned char)(lane + 64);
            }
            __syncthreads();
            const unsigned char* ksb = ws + C_KS + (size_t)bg * 8192 * 64;
            const unsigned char* vsb = ws + C_VST + (size_t)bg * 64 * 8192;
            const int curb = s0 >> 6;
            unsigned char* rb = R + wid * 16384;
            f32x4 oacc[4][4];
            float mcb[4], lcb[4];
#pragma unroll
            for (int cb = 0; cb < 4; ++cb) { mcb[cb] = -1e30f; lcb[cb] = 0.f;
#pragma unroll
                for (int dt = 0; dt < 4; ++dt) oacc[cb][dt] = zero4; }
            const int nsteps = U > wid ? ((U - wid + 3) >> 2) : 0;
            const int drow = lane >> 2, dpc = lane & 3;
            auto issue_step = [&](int s) {
                const int jb = sList[wid + 4 * s];
                unsigned char* sb = rb + (s & 1) * 8192 + lane * 16;
                const unsigned char* kt = ksb + (size_t)jb * 64 * 64;
                const unsigned char* vt = vsb + jb * 64;
#pragma unroll
                for (int i = 0; i < 4; ++i) {
                    const int row = drow + 16 * i;
                    glds16(kt + row * 64 + ((dpc ^ ((row >> 3) & 3)) << 4), sb + i * 1024);
                    glds16(vt + (size_t)row * 8192 + ((dpc ^ ((row >> 2) & 3)) << 4), sb + 4096 + i * 1024);
                }
            };
            int kofs[2], vofs[2];
#pragma unroll
            for (int c = 0; c < 2; ++c) {
                kofs[c] = (8 * (fr >> 2) + (fr & 3)) * 64 + (((2 * c + (fq >> 1)) ^ ((fr >> 2) & 3)) << 4) + (fq & 1) * 8;
                vofs[c] = fr * 64 + (((2 * c + (fq >> 1)) ^ ((fr >> 2) & 3)) << 4) + (fq & 1) * 8;
            }
            if (nsteps > 0 && !(mode & 8)) issue_step(0);
            for (int s = 0; s < nsteps; ++s) {
                if (s + 1 < nsteps) {
                    asm volatile("s_waitcnt lgkmcnt(0)" ::: "memory");
                    if (!(mode & 8)) issue_step(s + 1);
                    asm volatile("s_waitcnt vmcnt(8)" ::: "memory");
                } else asm volatile("s_waitcnt vmcnt(0)" ::: "memory");
                const int jb = __builtin_amdgcn_readfirstlane((int)sList[wid + 4 * s]);
                const unsigned char* sb = rb + (s & 1) * 8192;
                long kA[4][2];
#pragma unroll
                for (int mt = 0; mt < 4; ++mt)
#pragma unroll
                    for (int c = 0; c < 2; ++c) kA[mt][c] = *(const long*)(sb + 2048 * (mt >> 1) + 256 * (mt & 1) + kofs[c]);
                const bool masked = jb == curb;
                const int key0 = jb * 64 + fq * 8;
                unsigned wm = 0u, cm = 0u;
#pragma unroll
                for (int cb = 0; cb < 4; ++cb) {
                    wm |= ((sMask[64 + cb * 4 + (jb >> 5)] >> (jb & 31)) & 1u) << cb;
                    cm |= ((sMask[(cb * 4 + (fr >> 2)) * 4 + (jb >> 5)] >> (jb & 31)) & 1u) << cb;
                }
                wm = __builtin_amdgcn_readfirstlane(wm);
#pragma unroll
                for (int cb = 0; cb < 4; ++cb) {
                    if (((wm >> cb) & 1u) && !(mode & 16)) {
                        const bool con = (cm >> cb) & 1u;
                        const int ctok = s0 + cb * 4 + (fr >> 2);
                        const long q0 = *(const long*)(sQ + ((cb * 2 + 0) * 64 + lane) * 8), q1 = *(const long*)(sQ + ((cb * 2 + 1) * 64 + lane) * 8);
                        f32x4 st[4];
#pragma unroll
                        for (int mt = 0; mt < 4; ++mt) {
                            st[mt] = __builtin_amdgcn_mfma_f32_16x16x32_fp8_fp8(kA[mt][0], q0, zero4, 0, 0, 0);
                            st[mt] = __builtin_amdgcn_mfma_f32_16x16x32_fp8_fp8(kA[mt][1], q1, st[mt], 0, 0, 0);
                        }
                        float a[4][4];
#pragma unroll
                        for (int mt = 0; mt < 4; ++mt)
#pragma unroll
                            for (int j = 0; j < 4; ++j) a[mt][j] = (masked && (key0 + 32 * (mt >> 1) + 4 * (mt & 1) + j) > ctok) ? -1e30f : st[mt][j];
                        float mx = max3f(max3f(max3f(a[0][0], a[0][1], a[0][2]), max3f(a[0][3], a[1][0], a[1][1]), max3f(a[1][2], a[1][3], a[2][0])),
                                         max3f(max3f(a[2][1], a[2][2], a[2][3]), max3f(a[3][0], a[3][1], a[3][2]), a[3][3]), -1e30f);
                        mx = fqmax(con ? mx : -1e30f);
                        if (__any(mx > mcb[cb])) {
                            const float mn = fmaxf(mcb[cb], mx), al = __builtin_amdgcn_exp2f(mcb[cb] - mn);
                            lcb[cb] *= al; mcb[cb] = mn;
#pragma unroll
                            for (int dt = 0; dt < 4; ++dt) oacc[cb][dt] *= al;
                        }
                        float e[4][4];
#pragma unroll
                        for (int mt = 0; mt < 4; ++mt)
#pragma unroll
                            for (int j = 0; j < 4; ++j) {
                                const float x = __builtin_amdgcn_exp2f(a[mt][j] - mcb[cb]);
                                e[mt][j] = (masked && (key0 + 32 * (mt >> 1) + 4 * (mt & 1) + j) > ctok) ? 0.f : x;
                            }
                        float ps = sum16(e);
                        long pb[2];
#pragma unroll
                        for (int c = 0; c < 2; ++c) {
                            unsigned lo = __builtin_amdgcn_cvt_pk_fp8_f32(e[2 * c][0] * 64.f, e[2 * c][1] * 64.f, 0, false);
                            lo = __builtin_amdgcn_cvt_pk_fp8_f32(e[2 * c][2] * 64.f, e[2 * c][3] * 64.f, lo, true);
                            unsigned hi = __builtin_amdgcn_cvt_pk_fp8_f32(e[2 * c + 1][0] * 64.f, e[2 * c + 1][1] * 64.f, 0, false);
                            hi = __builtin_amdgcn_cvt_pk_fp8_f32(e[2 * c + 1][2] * 64.f, e[2 * c + 1][3] * 64.f, hi, true);
                            pb[c] = (long)(((unsigned long long)hi << 32) | lo);
                        }
                        if (!con) { ps = 0.f; pb[0] = 0; pb[1] = 0; }
                        lcb[cb] += ps;
#pragma unroll
                        for (int dt = 0; dt < 4; ++dt) {
                            oacc[cb][dt] = __builtin_amdgcn_mfma_f32_16x16x32_fp8_fp8(*(const long*)(sb + 4096 + dt * 1024 + vofs[0]), pb[0], oacc[cb][dt], 0, 0, 0);
                            oacc[cb][dt] = __builtin_amdgcn_mfma_f32_16x16x32_fp8_fp8(*(const long*)(sb + 4096 + dt * 1024 + vofs[1]), pb[1], oacc[cb][dt], 0, 0, 0);
                        }
                    }
                }
            }
            __syncthreads();
            {
                float* mrg = (float*)R;
                const int lane = opaque(tid) & 63, wid = opaque(tid) >> 6;
#pragma unroll
                for (int cb = 0; cb < 4; ++cb) {
                    if (cb != wid) {
                        float* slot = mrg + (wid * 3 + ((cb - wid - 1) & 3)) * 1152;
#pragma unroll
                        for (int dt = 0; dt < 4; ++dt) *(f32x4*)(slot + dt * 256 + lane * 4) = oacc[cb][dt];
                        slot[1024 + lane] = mcb[cb]; slot[1088 + lane] = lcb[cb];
                    }
                }
                __syncthreads();
                float mo = -1e30f, lo = 0.f;
#pragma unroll
                for (int cb = 0; cb < 4; ++cb) if (cb == wid) { mo = mcb[cb]; lo = lcb[cb];
#pragma unroll
                    for (int dt = 0; dt < 4; ++dt) os[dt] = oacc[cb][dt]; }
#pragma unroll
                for (int k = 1; k < 4; ++k) {
                    const int w2 = (wid + k) & 3;
                    const float* slot = mrg + (w2 * 3 + ((wid - w2 - 1) & 3)) * 1152;
                    const float m2 = slot[1024 + lane], l2 = slot[1088 + lane];
                    const float mn = fmaxf(mo, m2), f1 = __builtin_amdgcn_exp2f(mo - mn), f2 = __builtin_amdgcn_exp2f(m2 - mn);
                    lo = lo * f1 + l2 * f2; mo = mn;
#pragma unroll
                    for (int dt = 0; dt < 4; ++dt) { const f32x4 o2 = *(const f32x4*)(slot + dt * 256 + lane * 4); os[dt] = os[dt] * f1 + o2 * f2; }
                }
                lsel = fqsum(lo);
            }
#pragma unroll
            for (int dt = 0; dt < 4; ++dt) oc[dt] = *(const f32x4*)(park + (dt * 256 + opaque(tid)) * 4);
        }
        {
            const int tid2 = opaque((int)threadIdx.x), fr = tid2 & 15, fq = (tid2 >> 4) & 3;
            const int mytok = s0 + (tid2 >> 6) * 4 + (fr >> 2), myhead = fr & 3;
            const float gsel = GT[(size_t)(b * 8192 + mytok) * 48 + g * 12 + myhead * 3 + 1];
            const float g1 = (mode & 4) ? gsel / (lsel * 64.f) : 0.f;
            bf16_t* op = O + (size_t)(b * 8192 + mytok) * 1024 + g * 256 + myhead * 64 + fq * 4;
#pragma unroll
            for (int dt = 0; dt < 4; ++dt) {
                float r[4];
#pragma unroll
                for (int j = 0; j < 4; ++j) r[j] = oc[dt][j] + g1 * os[dt][j];
                *(uint2*)(op + dt * 16) = make_uint2(pack2(r[0], r[1]), pack2(r[2], r[3]));
            }
        }
        __syncthreads();
    }
}

__global__ void __launch_bounds__(256, 2) hybrid_fwd(Params p) {
    unsigned char* smem = smem_dyn + 16;
    cg::grid_group grid = cg::this_grid();
    if (threadIdx.x == 0) *(uint4*)smem_dyn = make_uint4(0u, 0u, 0u, 0u);
    __syncthreads();
    const XcdBarrier xbar = xcd_barrier_post((unsigned*)(p.ws + WS_CTL), (volatile LAS unsigned*)smem_dyn);
#define RUN_PHASE(N, CALL) if (p.ph_lo <= (N) && (N) < p.ph_hi) { if ((N) > p.ph_lo) { if ((N) == 1 && USE_CG_FIRST) grid.sync(); else xcd_barrier(xbar); } CALL; if ((REP_MASK >> (N)) & 1) { CALL; } }
    RUN_PHASE(0, phase_prologue(p, smem))
    RUN_PHASE(1, phase_gla_inproj(p, smem))
    RUN_PHASE(2, phase_gla_kv(p, smem))
    RUN_PHASE(3, phase_gla_scan(p, smem))
    RUN_PHASE(4, phase_gla_out(p, smem))
    RUN_PHASE(5, phase_outproj(p, (const bf16_t*)(p.ws + W_GO), p.in[0], smem))
    RUN_PHASE(6, phase_ln_router(p, 0, smem))
    RUN_PHASE(7, phase_moe_a(p, 0, smem))
    RUN_PHASE(8, phase_moe_b(p, 0, smem))
    RUN_PHASE(9, phase_ln2(p, 0, false, smem))
    RUN_PHASE(10, phase_nsa_inproj(p, smem))
    RUN_PHASE(11, phase_nsa_compress(p, smem))
    if (PROBE_MODE) { RUN_PHASE(12, phase_nsa_attn(p, smem, PROBE_MODE)) else {} phase_nsa_attn(p, smem, 7); } else { RUN_PHASE(12, phase_nsa_attn(p, smem)) }
    RUN_PHASE(13, phase_outproj(p, (const bf16_t*)(p.ws + W_NO), (const float*)(p.ws + WS_D), smem))
    RUN_PHASE(14, phase_ln_router(p, 1, smem))
    RUN_PHASE(15, phase_moe_a(p, 1, smem))
    RUN_PHASE(16, phase_moe_b(p, 1, smem))
    RUN_PHASE(17, phase_ln2(p, 1, true, smem))
}

extern "C" void kernel_launch(void* const* d_in, const int* in_sizes, int n_in, void* d_out, int out_size, void* d_ws, size_t ws_size, hipStream_t stream) {
    static int grid = 0;
    if (grid == 0) {
        if (n_in != 20 || out_size != NTOK * DM || ws_size < WS_END) {
            fprintf(stderr, "kernel_launch: unexpected problem: n_in %d out %d ws %zu (need %zu)\n", n_in, out_size, ws_size, (size_t)WS_END);
            grid = -1; return;
        }
        int dev = 0, cus = 0, per_cu = 0;
        hipGetDevice(&dev);
        hipDeviceGetAttribute(&cus, hipDeviceAttributeMultiprocessorCount, dev);
        hipFuncSetAttribute((const void*)hybrid_fwd, hipFuncAttributeMaxDynamicSharedMemorySize, LDS_BYTES);
        hipOccupancyMaxActiveBlocksPerMultiprocessor(&per_cu, (const void*)hybrid_fwd, 256, LDS_BYTES);
        if (per_cu < 1) { fprintf(stderr, "kernel_launch: occupancy query says %d blocks per CU\n", per_cu); per_cu = 1; }
        if (per_cu > 2) per_cu = 2;
        grid = cus * per_cu;
        fprintf(stderr, "kernel_launch: %d CUs x %d blocks\n", cus, per_cu);
    }
    if (grid < 0) return;
    hipMemsetAsync((unsigned char*)d_ws + WS_CTL, 0, 16 * KiB, stream);
    Params p{};
    for (int i = 0; i < 20; ++i) p.in[i] = (const float*)d_in[i];
    p.out = (float*)d_out; p.ws = (unsigned char*)d_ws;
#if MK_ONE_LAUNCH
    p.ph_lo = 0; p.ph_hi = NPHASE;
    void* args[] = {&p};
    hipError_t e = hipLaunchCooperativeKernel((const void*)hybrid_fwd, dim3(grid), dim3(256), args, LDS_BYTES, stream);
    if (e != hipSuccess) fprintf(stderr, "cooperative launch failed: %s (grid %d)\n", hipGetErrorString(e), grid);
#else
    for (int ph = 0; ph < NPHASE; ++ph) {
        p.ph_lo = ph; p.ph_hi = ph + 1;
        hipLaunchKernelGGL(hybrid_fwd, dim3(grid), dim3(256), LDS_BYTES, stream, p);
    }
#endif
}
```

```cpp
#include <hip/hip_runtime.h>
#include <hip/hip_cooperative_groups.h>
#include <cstdio>
#include <cstdint>
namespace cg = cooperative_groups;

#ifndef REP_MASK
#define REP_MASK 0
#endif
#ifndef USE_CG_FIRST
#define USE_CG_FIRST 0
#endif
#ifndef PROBE_MODE
#define PROBE_MODE 0
#endif
#ifndef MK_ONE_LAUNCH
#define MK_ONE_LAUNCH 1
#endif

typedef unsigned short bf16_t;
typedef short bf16x8 __attribute__((ext_vector_type(8)));
typedef float f32x4 __attribute__((ext_vector_type(4)));

constexpr int DM = 1024, SEQ = 8192, NTOK = 16384;
constexpr float DN_ALPHA = 1.41421356237309515f;
constexpr float LN_EPS = 1e-5f;

constexpr size_t KiB = 1024, MiB = 1024 * 1024;
constexpr size_t WS_CTL = 0;
constexpr size_t WS_CNT = 14848;
constexpr size_t WS_FLG = 16 * KiB;
constexpr int FLG_TILES = 288;
constexpr size_t WS_AQ = 60 * KiB;
constexpr size_t WS_ROPE = 64 * KiB;
constexpr size_t WS_WRT = 576 * KiB;
constexpr size_t WS_BIASC = 640 * KiB;
constexpr size_t WS_GLOW = 1 * MiB;
constexpr size_t WS_DEC = 2 * MiB;
constexpr size_t WS_PW = 2 * MiB + 512 * KiB;
constexpr size_t WS_KCMP = 3 * MiB;
constexpr size_t WS_VCMPT = 3 * MiB + 512 * KiB;
constexpr size_t WS_LIST = 4 * MiB;
constexpr size_t WS_GT = 5 * MiB;
constexpr size_t WS_W = 8 * MiB;
constexpr size_t W_GI = WS_W;
constexpr size_t W_GO = W_GI + (size_t)3200 * 1024 * 2;
constexpr size_t W_NI = W_GO + (size_t)1024 * 1024 * 2;
constexpr size_t W_NO = W_NI + (size_t)2688 * 1024 * 2;
constexpr size_t W_CK1 = W_NO + (size_t)1024 * 1024 * 2;
constexpr size_t W_CV1 = W_CK1 + (size_t)256 * 2048 * 2;
constexpr size_t W_CK2 = W_CV1 + (size_t)256 * 2048 * 2;
constexpr size_t W_CV2 = W_CK2 + (size_t)64 * 256 * 2;
constexpr size_t W_MOE = W_CV2 + (size_t)64 * 256 * 2;
constexpr size_t MOE_E_BYTES = (size_t)(512 * 1024 + 1024 * 256) * 2;
constexpr size_t W_END = W_MOE + 16 * MOE_E_BYTES;
constexpr size_t WS_B = 50 * MiB;
constexpr size_t WS_C = 82 * MiB;
constexpr size_t WS_D = 178 * MiB;
constexpr size_t WS_END = 242 * MiB;
static_assert(W_END <= WS_B, "weights overflow");
constexpr size_t C_QK = WS_C;
constexpr size_t C_VT = WS_C + 32 * MiB;
constexpr size_t C_R = WS_C + 64 * MiB;
constexpr size_t C_QN = WS_C;
constexpr size_t C_KC = WS_C + 32 * MiB;
constexpr size_t C_VC = C_KC + 8 * MiB;
constexpr size_t C_KS = C_VC + 8 * MiB;
constexpr size_t C_VST = C_KS + 8 * MiB;
constexpr size_t C_KW = C_VST + 8 * MiB;
constexpr size_t C_VWT = C_KW + 8 * MiB;
constexpr size_t C_PARK = WS_C + 80 * MiB;

constexpr int LDS_BYTES = 76 * 1024 + 16;
constexpr int NPHASE = 19;

struct Params {
    const float* in[20];
    float* out;
    unsigned char* ws;
    int ph_lo, ph_hi;
};

extern __shared__ __attribute__((aligned(16))) unsigned char smem_dyn[];

__device__ __forceinline__ bf16_t f2bf(float f) {
    unsigned u = __float_as_uint(f);
    u += 0x7FFFu + ((u >> 16) & 1u);
    return (bf16_t)(u >> 16);
}
__device__ __forceinline__ float bf2f(bf16_t h) { return __uint_as_float(((unsigned)h) << 16); }
typedef __bf16 bf16v2 __attribute__((ext_vector_type(2)));
typedef float f32v2 __attribute__((ext_vector_type(2)));
__device__ __forceinline__ unsigned pack2(float lo, float hi) { const f32v2 f = {lo, hi}; return __builtin_bit_cast(unsigned, __builtin_convertvector(f, bf16v2)); }
__device__ __forceinline__ float max3f(float a, float b, float c) { return __builtin_fmaxf(__builtin_fmaxf(a, b), c); }
__device__ __forceinline__ float silu_f(float x) { return x / (1.f + __expf(-x)); }
__device__ __forceinline__ float sigmoid_f(float x) { return 1.f / (1.f + __expf(-x)); }
__device__ __forceinline__ float logsig_f(float z) { return fminf(z, 0.f) - 0.6931471805599453f * __builtin_amdgcn_logf(1.f + __builtin_amdgcn_exp2f(-1.4426950408889634f * fabsf(z))); }
template <int CTRL> __device__ __forceinline__ float dpp_f(float v) {
    return __int_as_float(__builtin_amdgcn_update_dpp(0, __float_as_int(v), CTRL, 0xF, 0xF, true));
}
__device__ __forceinline__ float rmax16(float v) {
    v = fmaxf(v, dpp_f<0xB1>(v)); v = fmaxf(v, dpp_f<0x4E>(v)); v = fmaxf(v, dpp_f<0x141>(v)); v = fmaxf(v, dpp_f<0x140>(v)); return v;
}
__device__ __forceinline__ float rsum16(float v) {
    v += dpp_f<0xB1>(v); v += dpp_f<0x4E>(v); v += dpp_f<0x141>(v); v += dpp_f<0x140>(v); return v;
}
__device__ __forceinline__ float fqsum(float v);
__device__ __forceinline__ float wsum64(float v) { return fqsum(rsum16(v)); }
__device__ __forceinline__ float fqmax(float v) {
    unsigned u = __float_as_uint(v);
    auto r = __builtin_amdgcn_permlane16_swap(u, u, false, false);
    u = __float_as_uint(fmaxf(__uint_as_float(r[0]), __uint_as_float(r[1])));
    auto s = __builtin_amdgcn_permlane32_swap(u, u, false, false);
    return fmaxf(__uint_as_float(s[0]), __uint_as_float(s[1]));
}
__device__ __forceinline__ float fqsum(float v) {
    unsigned u = __float_as_uint(v);
    auto r = __builtin_amdgcn_permlane16_swap(u, u, false, false);
    u = __float_as_uint(__uint_as_float(r[0]) + __uint_as_float(r[1]));
    auto s = __builtin_amdgcn_permlane32_swap(u, u, false, false);
    return __uint_as_float(s[0]) + __uint_as_float(s[1]);
}
__device__ __forceinline__ float sum16(const float (&e)[4][4]) {
    return (((e[0][0] + e[0][1]) + (e[0][2] + e[0][3])) + ((e[1][0] + e[1][1]) + (e[1][2] + e[1][3]))) +
           (((e[2][0] + e[2][1]) + (e[2][2] + e[2][3])) + ((e[3][0] + e[3][1]) + (e[3][2] + e[3][3])));
}
__device__ __forceinline__ int opaque(int x) { asm volatile("" : "+v"(x)); return x; }
__device__ __forceinline__ void glds16(const void* g, void* l) {
    __builtin_amdgcn_global_load_lds((const unsigned*)g, (unsigned*)l, 16, 0, 0);
}
__device__ __forceinline__ f32x4 mfma16(bf16x8 a, bf16x8 b, f32x4 c) { return __builtin_amdgcn_mfma_f32_16x16x32_bf16(a, b, c, 0, 0, 0); }
__device__ __forceinline__ bf16x8 ld8(const bf16_t* p) { return *(const bf16x8*)p; }
__device__ __forceinline__ float4 ldnt4(const float* p) { const f32x4 v = __builtin_nontemporal_load((const f32x4*)p); return make_float4(v[0], v[1], v[2], v[3]); }


#define XB_TMO      128
#define XB_XCNT(j)  (256  + 64 * (j))
#define XB_XSUB(j)  (1280 + 64 * (j))
#define XB_XGEN(j)  (2304 + 64 * (j))
#define XB_TOP      3328
#define XB_TOPGEN   3392
#define XCD_BAR_WORDS 3456
#define XB_SPIN_CAP (1u << 18)
#define LAS __attribute__((address_space(3)))
__device__ __forceinline__ unsigned xb_ld(unsigned* p)              { return __hip_atomic_load(p, __ATOMIC_RELAXED, __HIP_MEMORY_SCOPE_AGENT); }
__device__ __forceinline__ unsigned xb_add(unsigned* p, unsigned v) { return __hip_atomic_fetch_add(p, v, __ATOMIC_RELAXED, __HIP_MEMORY_SCOPE_AGENT); }
__device__ __forceinline__ unsigned xb_xcc_id() { return (unsigned)__builtin_amdgcn_s_getreg((3 << 11) | 20) & 0xFu; }
#define XB_SPIN(cond, bar) do { unsigned _sp = 0; while (cond) { __builtin_amdgcn_s_sleep(1); \
    if ((++_sp & 255u) == 0u) { if (xb_ld(&(bar)[XB_TMO])) break; if (_sp > XB_SPIN_CAP) { atomicAdd(&(bar)[XB_TMO], 1u); break; } } } } while (0)
struct XcdBarrier { unsigned* bar; unsigned x; volatile LAS unsigned* st; };
__device__ __forceinline__ XcdBarrier xcd_barrier_post(unsigned* bar, volatile LAS unsigned* st) {
    XcdBarrier b; b.bar = bar; b.x = xb_xcc_id(); b.st = st;
    if (threadIdx.x == 0) (void)xb_add(&bar[XB_XCNT(b.x)], 1u);
    return b;
}
__device__ __forceinline__ void xcd_barrier_complete(unsigned* bar, unsigned x, unsigned& nloc, unsigned& nx) {
    const unsigned G = gridDim.x * gridDim.y * gridDim.z;
    unsigned sum, cnt, mine, sp = 0u;
    for (;;) {
        sum = 0u; cnt = 0u; mine = 0u;
#pragma unroll
        for (unsigned j = 0; j < 16; ++j) { const unsigned c = xb_ld(&bar[XB_XCNT(j)]); sum += c; cnt += (c > 0u) ? 1u : 0u; mine = (j == x) ? c : mine; }
        if (sum == G) break;
        __builtin_amdgcn_s_sleep(1);
        if ((++sp & 255u) == 0u) { if (xb_ld(&bar[XB_TMO])) break; if (sp > XB_SPIN_CAP) { atomicAdd(&bar[XB_TMO], 1u); break; } }
    }
    nloc = mine > 0u ? mine : 1u; nx = cnt > 0u ? cnt : 1u;
}
__device__ __forceinline__ void xcd_barrier(const XcdBarrier& b) {
    asm volatile("s_waitcnt vmcnt(0)" ::: "memory");
    __syncthreads();
    if (threadIdx.x == 0) {
        unsigned* bar = b.bar;
        __builtin_amdgcn_s_waitcnt(0);
        unsigned nloc = b.st[0], nx = b.st[1];
        if (nloc == 0u) { xcd_barrier_complete(bar, b.x, nloc, nx); b.st[0] = nloc; b.st[1] = nx; }
        const unsigned old = xb_add(&bar[XB_XSUB(b.x)], 1u);
        const unsigned gen = old / nloc;
        if (old + 1u == (gen + 1u) * nloc) {
            __builtin_amdgcn_fence(__ATOMIC_RELEASE, "agent");
            asm volatile("s_waitcnt vmcnt(0)" ::: "memory");
            const unsigned og = xb_add(&bar[XB_TOP], 1u);
            const unsigned tg = og / nx;
            if (og + 1u == (tg + 1u) * nx) xb_add(&bar[XB_TOPGEN], 1u);
            else XB_SPIN(xb_ld(&bar[XB_TOPGEN]) == tg, bar);
            __builtin_amdgcn_fence(__ATOMIC_ACQUIRE, "agent");
            xb_add(&bar[XB_XGEN(b.x)], 1u);
            asm volatile("s_waitcnt vmcnt(0)" ::: "memory");
        } else {
            XB_SPIN(xb_ld(&bar[XB_XGEN(b.x)]) == gen, bar);
            __builtin_amdgcn_fence(__ATOMIC_ACQUIRE, "agent");
            asm volatile("s_waitcnt vmcnt(0)" ::: "memory");
        }
    }
    __syncthreads();
}

template <class Pre>
__device__ __forceinline__ void xcd_barrier_pre(const XcdBarrier& b, Pre pre) {
    asm volatile("s_waitcnt vmcnt(0)" ::: "memory");
    __syncthreads();
    if (threadIdx.x == 0) {
        unsigned* bar = b.bar;
        __builtin_amdgcn_s_waitcnt(0);
        unsigned nloc = b.st[0], nx = b.st[1];
        if (nloc == 0u) { xcd_barrier_complete(bar, b.x, nloc, nx); b.st[0] = nloc; b.st[1] = nx; }
        const unsigned old = xb_add(&bar[XB_XSUB(b.x)], 1u);
        const unsigned gen = old / nloc;
        if (old + 1u == (gen + 1u) * nloc) {
            __builtin_amdgcn_fence(__ATOMIC_RELEASE, "agent");
            asm volatile("s_waitcnt vmcnt(0)" ::: "memory");
            const unsigned og = xb_add(&bar[XB_TOP], 1u);
            const unsigned tg = og / nx;
            if (og + 1u == (tg + 1u) * nx) xb_add(&bar[XB_TOPGEN], 1u);
            else XB_SPIN(xb_ld(&bar[XB_TOPGEN]) == tg, bar);
            __builtin_amdgcn_fence(__ATOMIC_ACQUIRE, "agent");
            xb_add(&bar[XB_XGEN(b.x)], 1u);
            asm volatile("s_waitcnt vmcnt(0)" ::: "memory");
        } else {
            XB_SPIN(xb_ld(&bar[XB_XGEN(b.x)]) == gen, bar);
            __builtin_amdgcn_fence(__ATOMIC_ACQUIRE, "agent");
            asm volatile("s_waitcnt vmcnt(0)" ::: "memory");
        }
    } else if (threadIdx.x >= 64) pre();
    __syncthreads();
}

template <int BM, bool A_LDS, int NS = 4, bool SWAP = false>
__device__ __forceinline__ void gemm_loop(f32x4 (&acc)[BM / 32][4], const bf16_t* a0, const bf16_t* a1, const bf16_t* b0, const bf16_t* b1,
                                          int nk, unsigned char* lds, const unsigned char* hA, int hstride,
                                          const bf16_t* a2 = nullptr, const bf16_t* a3 = nullptr, int tid_in = -1) {
    constexpr int MI = BM / 32;
    constexpr int A_BYTES = A_LDS ? 0 : BM * 64, STAGE = A_BYTES + 128 * 64;
    constexpr int G = (A_LDS ? 0 : BM / 64) + 2;
    static_assert(!(BM == 256 && NS != 3), "256-row tiles: 3 stages of 24 KiB");
    const int tid = tid_in >= 0 ? tid_in : (int)threadIdx.x, lane = tid & 63, wid = tid >> 6, wr = wid >> 1, wc = wid & 1, fr = lane & 15, fq = lane >> 4;
#pragma unroll
    for (int m = 0; m < MI; ++m)
#pragma unroll
        for (int n = 0; n < 4; ++n) acc[m][n] = (f32x4){0.f, 0.f, 0.f, 0.f};
    const int srow = tid >> 2, lcol = ((tid & 3) ^ (((srow >> 3) & 1) << 1)) * 8 - (tid & 3) * 8;
    auto stage = [&](int slot, int kt) {
        unsigned char* base = lds + slot * STAGE;
        if (!A_LDS) {
            glds16(a0 + kt * 32 + lcol, base + tid * 16);
            if (BM >= 128) glds16(a1 + kt * 32 + lcol, base + 4096 + tid * 16);
            if (BM == 256) {
                glds16((a2 ? a2 : a0 + 2 * (a1 - a0)) + kt * 32 + lcol, base + 8192 + tid * 16);
                glds16((a3 ? a3 : a0 + 3 * (a1 - a0)) + kt * 32 + lcol, base + 12288 + tid * 16);
            }
        }
        glds16(b0 + kt * 32 + lcol, base + A_BYTES + tid * 16);
        glds16(b1 + kt * 32 + lcol, base + A_BYTES + 4096 + tid * 16);
    };
    asm volatile("s_waitcnt lgkmcnt(0)" ::: "memory");
    __builtin_amdgcn_s_barrier();
    stage(0, 0);
    if (nk > 1) stage(1, 1);
    if (NS == 4 && nk > 2) stage(2, 2);
    const int rsw = (((fr >> 3) & 1) << 1);
    for (int kt = 0; kt < nk; ++kt) {
        const int ahead = nk - 1 - kt;
        if (NS == 4 && ahead >= 2) { if (G == 4) asm volatile("s_waitcnt vmcnt(8)" ::: "memory"); else if (G == 3) asm volatile("s_waitcnt vmcnt(6)" ::: "memory"); else asm volatile("s_waitcnt vmcnt(4)" ::: "memory"); }
        else if (ahead >= 1) { if (G == 6) asm volatile("s_waitcnt vmcnt(6)" ::: "memory"); else if (G == 4) asm volatile("s_waitcnt vmcnt(4)" ::: "memory"); else if (G == 3) asm volatile("s_waitcnt vmcnt(3)" ::: "memory"); else asm volatile("s_waitcnt vmcnt(2)" ::: "memory"); }
        else asm volatile("s_waitcnt vmcnt(0)" ::: "memory");
        asm volatile("s_waitcnt lgkmcnt(0)" ::: "memory");
        __builtin_amdgcn_s_barrier();
        asm volatile("" ::: "memory");
        if (kt + NS - 1 < nk) stage((kt + NS - 1) % NS, kt + NS - 1);
        const unsigned char* base = lds + (kt % NS) * STAGE;
        bf16x8 af[MI], bfr[4];
#pragma unroll
        for (int m = 0; m < MI; ++m) {
            if (A_LDS) af[m] = *(const bf16x8*)(hA + (size_t)(wr * (BM / 2) + m * 16 + fr) * hstride + (kt * 32 + fq * 8) * 2);
            else af[m] = *(const bf16x8*)(base + (wr * (BM / 2) + m * 16 + fr) * 64 + ((fq ^ rsw) << 4));
        }
#pragma unroll
        for (int n = 0; n < 4; ++n) bfr[n] = *(const bf16x8*)(base + A_BYTES + (wc * 64 + n * 16 + fr) * 64 + ((fq ^ rsw) << 4));
#pragma unroll
        for (int m = 0; m < MI; ++m)
#pragma unroll
            for (int n = 0; n < 4; ++n) acc[m][n] = SWAP ? mfma16(bfr[n], af[m], acc[m][n]) : mfma16(af[m], bfr[n], acc[m][n]);
    }
}

constexpr int GBM = 256, GMI = GBM / 32;
template <bool SWAP = false, class Epi>
__device__ __forceinline__ void dense_gemm_phase(const bf16_t* A, int lda, const bf16_t* Bt, int K, int NT, Epi epi, unsigned char* smem) {
    const int tid = threadIdx.x, lane = tid & 63, wid = tid >> 6, wr = wid >> 1, wc = wid & 1, fr = lane & 15, fq = lane >> 4;
    const int ntiles = (NTOK / GBM) * NT;
    for (int tile = blockIdx.x; tile < ntiles; tile += gridDim.x) {
        const int xcd = tile & 7, tidx = tile >> 3;
        const int mt = (tidx / NT) * 8 + xcd, nt = tidx % NT;
        const bf16_t* a0 = A + (size_t)(mt * GBM + (tid >> 2)) * lda + (tid & 3) * 8;
        const bf16_t* a1 = a0 + (size_t)64 * lda;
        const bf16_t* b0 = Bt + (size_t)(nt * 128 + (tid >> 2)) * K + (tid & 3) * 8;
        const bf16_t* b1 = b0 + (size_t)64 * K;
        f32x4 acc[GMI][4];
        gemm_loop<GBM, false, 3, SWAP>(acc, a0, a1, b0, b1, K / 32, smem, nullptr, 0);
        epi(acc, mt * GBM + wr * (GBM / 2), nt, wc, fr, fq);
    }
}

template <int BM, bool SWAP = false>
__device__ __forceinline__ void gemm_loop64(f32x4 (&acc)[BM / 32][4], const bf16_t* ap, size_t astr, const bf16_t* bp, size_t bstr, int nk, unsigned char* lds) {
    constexpr int MI = BM / 32, A_BYTES = BM * 128, STAGE = A_BYTES + 128 * 128;
    const int tid = threadIdx.x, lane = tid & 63, wid = tid >> 6, wr = wid >> 1, wc = wid & 1, fr = lane & 15, fq = lane >> 4;
#pragma unroll
    for (int m = 0; m < MI; ++m)
#pragma unroll
        for (int n = 0; n < 4; ++n) acc[m][n] = (f32x4){0.f, 0.f, 0.f, 0.f};
    auto stage = [&](int slot, int kt) {
        unsigned char* base = lds + slot * STAGE + tid * 16;
#pragma unroll
        for (int i = 0; i < MI; ++i) glds16(ap + i * astr + kt * 64, base + i * 4096);
#pragma unroll
        for (int i = 0; i < 4; ++i) glds16(bp + i * bstr + kt * 64, base + A_BYTES + i * 4096);
    };
    asm volatile("s_waitcnt lgkmcnt(0)" ::: "memory");
    __builtin_amdgcn_s_barrier();
    stage(0, 0);
    if (nk > 1) stage(1, 1);
    const int sw = fr >> 1;
    for (int kt = 0; kt < nk; ++kt) {
        if (kt + 1 < nk) { if (MI == 4) asm volatile("s_waitcnt vmcnt(8)" ::: "memory"); else asm volatile("s_waitcnt vmcnt(6)" ::: "memory"); }
        else asm volatile("s_waitcnt vmcnt(0)" ::: "memory");
        __builtin_amdgcn_s_barrier();
        asm volatile("" ::: "memory");
        const unsigned char* base = lds + (kt & 1) * STAGE;
        bf16x8 af[MI][2], bfr[4][2];
#pragma unroll
        for (int kk = 0; kk < 2; ++kk) {
#pragma unroll
            for (int m = 0; m < MI; ++m) af[m][kk] = *(const bf16x8*)(base + (wr * (BM / 2) + m * 16 + fr) * 128 + (((kk * 4 + fq) ^ sw) << 4));
#pragma unroll
            for (int n = 0; n < 4; ++n) bfr[n][kk] = *(const bf16x8*)(base + A_BYTES + (wc * 64 + n * 16 + fr) * 128 + (((kk * 4 + fq) ^ sw) << 4));
        }
        if (kt + 2 < nk) {
            asm volatile("s_waitcnt lgkmcnt(0)" ::: "memory");
            __builtin_amdgcn_s_barrier();
            asm volatile("" ::: "memory");
            stage(kt & 1, kt + 2);
        }
#pragma unroll
        for (int kk = 0; kk < 2; ++kk)
#pragma unroll
            for (int m = 0; m < MI; ++m)
#pragma unroll
                for (int n = 0; n < 4; ++n) acc[m][n] = SWAP ? mfma16(bfr[n][kk], af[m][kk], acc[m][n]) : mfma16(af[m][kk], bfr[n][kk], acc[m][n]);
    }
}
template <bool SWAP = false, class Epi>
__device__ __forceinline__ void dense_gemm_phase64(const bf16_t* A, int lda, const bf16_t* Bt, int K, int NT, Epi epi, unsigned char* smem) {
    const int tid = threadIdx.x, lane = tid & 63, wid = tid >> 6, wr = wid >> 1, wc = wid & 1, fr = lane & 15, fq = lane >> 4;
    const int ntiles = (NTOK / 128) * NT;
    const int sch = ((tid & 7) ^ ((tid >> 4) & 7)) * 8;
    for (int tile = blockIdx.x; tile < ntiles; tile += gridDim.x) {
        const int xcd = tile & 7, tidx = tile >> 3;
        const int mt = (tidx / NT) * 8 + xcd, nt = tidx % NT;
        const bf16_t* ap = A + (size_t)(mt * 128 + (tid >> 3)) * lda + sch;
        const bf16_t* bp = Bt + (size_t)(nt * 128 + (tid >> 3)) * K + sch;
        f32x4 acc[4][4];
        gemm_loop64<128, SWAP>(acc, ap, (size_t)32 * lda, bp, (size_t)32 * K, K / 64, smem);
        epi(acc, mt * 128 + wr * 64, nt, wc, fr, fq);
    }
}

__device__ __forceinline__ void xpose_tile(const float* src, const float* src2, int ld, int nsrc, int kind, bf16_t* dst, int ndst, int K, int k0, int n0, unsigned char* smem) {
    bf16_t* T = (bf16_t*)smem;
    const int tid = threadIdx.x, nq = tid & 15, kb = tid >> 4;
    float4 v[2][4];
#pragma unroll
    for (int hh = 0; hh < 2; ++hh) {
        const int nd = n0 + hh * 64 + nq * 4;
        const float* sp = src; int ns;
        if (kind == 0) ns = nd < nsrc ? nd : -1;
        else if (kind == 1) ns = nd < 2048 ? nd : (nd < 3072 ? nd + 16 : (nd < 3088 ? nd - 1024 : -1));
        else { const int ch = nd >> 6, w = nd & 63; if (w < 32) ns = ch * 32 + w; else { ns = ch * 32 + w - 32; sp = src2; } }
#pragma unroll
        for (int i = 0; i < 4; ++i) v[hh][i] = ns >= 0 ? ldnt4(sp + (size_t)(k0 + kb + 16 * i) * ld + ns) : make_float4(0.f, 0.f, 0.f, 0.f);
    }
#pragma unroll
    for (int hh = 0; hh < 2; ++hh)
#pragma unroll
        for (int i = 0; i < 4; ++i) {
            const int kk = kb + 16 * i, r = hh * 64 + nq * 4;
            T[(r + 0) * 66 + kk] = f2bf(v[hh][i].x); T[(r + 1) * 66 + kk] = f2bf(v[hh][i].y);
            T[(r + 2) * 66 + kk] = f2bf(v[hh][i].z); T[(r + 3) * 66 + kk] = f2bf(v[hh][i].w);
        }
    __syncthreads();
#pragma unroll
    for (int hh = 0; hh < 2; ++hh) {
        const int n = hh * 64 + (tid >> 2), ks = (tid & 3) * 16;
        if (n0 + n < ndst) {
            unsigned w[8];
#pragma unroll
            for (int q = 0; q < 8; ++q) w[q] = *(const unsigned*)(T + n * 66 + ks + q * 2);
            uint4* d = (uint4*)(dst + (size_t)(n0 + n) * K + k0 + ks);
            d[0] = make_uint4(w[0], w[1], w[2], w[3]); d[1] = make_uint4(w[4], w[5], w[6], w[7]);
        }
    }
    __syncthreads();
}
__device__ __forceinline__ void convert_moe_tile(const Params& p, int L, int it, unsigned char* smem) {
    const int e = it / 96, r = it % 96;
    unsigned char* eb = p.ws + W_MOE + (size_t)e * MOE_E_BYTES;
    if (r < 64) {
        const int kt = r >> 2, ntile = r & 3;
        const float* sg = p.in[15] + (size_t)(L * 16 + e) * 1024 * 256, *su = p.in[16] + (size_t)(L * 16 + e) * 1024 * 256;
        xpose_tile(sg, su, 256, 256, 2, (bf16_t*)eb, 512, 1024, kt * 64, ntile * 128, smem);
    } else {
        const int r2 = r - 64, kt = r2 >> 3, ntile = r2 & 7;
        const float* sd = p.in[17] + (size_t)(L * 16 + e) * 256 * 1024;
        xpose_tile(sd, nullptr, 1024, 1024, 0, (bf16_t*)(eb + (size_t)512 * 1024 * 2), 1024, 256, kt * 64, ntile * 128, smem);
    }
}
__device__ __forceinline__ void phase_prologue(const Params& p, unsigned char* smem) {
    const int tid = threadIdx.x;
    unsigned char* ws = p.ws;
    constexpr int J0 = 16 * 25, J1 = 128, J2 = 16 * 21, J3 = 128, J4 = 64, J5 = 64, J6 = 4, J7 = 4, J8 = 0, J9 = 2048, J10 = 256, J11 = 64, J12 = 32;
    constexpr int TOTAL = J0 + J1 + J2 + J3 + J4 + J5 + J6 + J7 + J8 + J9 + J10 + J11 + J12;
    for (int item = blockIdx.x; item < TOTAL; item += gridDim.x) {
        int it = item;
        if (it < J12) {
            const int which = it >> 4, hc = it & 15, ks = tid >> 4, cc = tid & 15, h = hc * 16 + cc;
            const float* w1 = p.in[which ? 9 : 7]; const float* pe = p.in[11];
            float s = 0.f;
            for (int kk0 = ks * 128; kk0 < ks * 128 + 128; kk0 += 32) {
                float wv[32], pv[32];
#pragma unroll
                for (int j = 0; j < 32; ++j) { wv[j] = w1[(size_t)(kk0 + j) * 256 + h]; pv[j] = pe[kk0 + j]; }
#pragma unroll
                for (int j = 0; j < 32; ++j) s += pv[j] * wv[j];
            }
            float* red = (float*)smem;
            red[tid] = s;
            __syncthreads();
            if (tid < 16) { float t = 0.f; for (int q = 0; q < 16; ++q) t += red[q * 16 + tid]; ((float*)(ws + WS_BIASC))[which * 256 + hc * 16 + tid] = t; }
            __syncthreads();
            continue;
        } it -= J12;
        if (it < J10) {
            const int idx = it * 256 + tid, pos = idx >> 3, i = idx & 7;
            const float inv = powf(500000.0f, -(float)i * 0.125f);
            const float ang = (float)pos * inv;
            float sn, cs; sincosf(ang, &sn, &cs);
            ((float2*)(ws + WS_ROPE))[idx] = make_float2(cs, sn);
            continue;
        } it -= J10;
        if (it < J11) {
            const int idx = it * 256 + tid, e = idx >> 10, c = idx & 1023;
            ((float*)(ws + WS_WRT))[idx] = p.in[13][c * 16 + e];
            continue;
        } it -= J11;
        if (it < J0) { xpose_tile(p.in[1], nullptr, 3088, 3088, 1, (bf16_t*)(ws + W_GI), 3200, 1024, (it / 25) * 64, (it % 25) * 128, smem); continue; } it -= J0;
        if (it < J1) { xpose_tile(p.in[5], nullptr, 1024, 1024, 0, (bf16_t*)(ws + W_GO), 1024, 1024, (it / 8) * 64, (it % 8) * 128, smem); continue; } it -= J1;
        if (it < J2) { xpose_tile(p.in[6], nullptr, 2608, 2608, 0, (bf16_t*)(ws + W_NI), 2688, 1024, (it / 21) * 64, (it % 21) * 128, smem); continue; } it -= J2;
        if (it < J3) { xpose_tile(p.in[12], nullptr, 1024, 1024, 0, (bf16_t*)(ws + W_NO), 1024, 1024, (it / 8) * 64, (it % 8) * 128, smem); continue; } it -= J3;
        if (it < J4) { xpose_tile(p.in[7], nullptr, 256, 256, 0, (bf16_t*)(ws + W_CK1), 256, 2048, (it / 2) * 64, (it % 2) * 128, smem); continue; } it -= J4;
        if (it < J5) { xpose_tile(p.in[9], nullptr, 256, 256, 0, (bf16_t*)(ws + W_CV1), 256, 2048, (it / 2) * 64, (it % 2) * 128, smem); continue; } it -= J5;
        if (it < J6) { xpose_tile(p.in[8], nullptr, 64, 64, 0, (bf16_t*)(ws + W_CK2), 64, 256, it * 64, 0, smem); continue; } it -= J6;
        if (it < J7) { xpose_tile(p.in[10], nullptr, 64, 64, 0, (bf16_t*)(ws + W_CV2), 64, 256, it * 64, 0, smem); continue; } it -= J7;
        if (it < J8) { convert_moe_tile(p, 0, it, smem); continue; } it -= J8;
        if (it < J9) {
            float4 v[8];
#pragma unroll
            for (int u = 0; u < 4; ++u) { const size_t e0 = (size_t)it * 8192 + u * 2048 + tid * 8; v[2 * u] = ldnt4(p.in[0] + e0); v[2 * u + 1] = ldnt4(p.in[0] + e0 + 4); }
#pragma unroll
            for (int u = 0; u < 4; ++u) {
                const size_t e0 = (size_t)it * 8192 + u * 2048 + tid * 8;
                *(uint4*)((bf16_t*)(ws + WS_B) + e0) = make_uint4(pack2(v[2 * u].x, v[2 * u].y), pack2(v[2 * u].z, v[2 * u].w), pack2(v[2 * u + 1].x, v[2 * u + 1].y), pack2(v[2 * u + 1].z, v[2 * u + 1].w));
            }
            continue;
        } it -= J9;
    }
}

__device__ __forceinline__ void phase_gla_inproj(const Params& p, unsigned char* smem) {
    unsigned char* ws = p.ws;
    bf16_t* QK = (bf16_t*)(ws + C_QK); bf16_t* VT = (bf16_t*)(ws + C_VT); bf16_t* R = (bf16_t*)(ws + C_R); float* GLOW = (float*)(ws + WS_GLOW);
    auto epi = [&](auto& acc, int row0, int nt, int wc, int fr, int fq) {
        constexpr int MI = sizeof(acc) / sizeof(acc[0]);
#pragma unroll
        for (int m = 0; m < MI; ++m)
#pragma unroll
            for (int n = 0; n < 4; ++n) {
                const int r0 = row0 + m * 16 + fq * 4;
                const int c = nt * 128 + wc * 64 + n * 16 + fr;
                if (nt < 8) {
                    const float sc = nt < 4 ? 0.08838834764831845f : 1.f;
#pragma unroll
                    for (int j = 0; j < 4; ++j) QK[(size_t)(r0 + j) * 1024 + c] = f2bf(acc[m][n][j] * sc);
                } else if (nt < 16) {
                    const int vcol = c - 1024, chunk = r0 >> 6, t = r0 & 63;
                    *(uint2*)(VT + ((size_t)chunk * 1024 + vcol) * 64 + t) = make_uint2(pack2(acc[m][n][0], acc[m][n][1]), pack2(acc[m][n][2], acc[m][n][3]));
                } else if (nt < 24) {
#pragma unroll
                    for (int j = 0; j < 4; ++j) R[(size_t)(r0 + j) * 1024 + (c - 2048)] = f2bf(acc[m][n][j]);
                } else {
                    if (wc == 0 && n == 0) {
#pragma unroll
                        for (int j = 0; j < 4; ++j) GLOW[(size_t)(r0 + j) * 16 + fr] = acc[m][n][j];
                    }
                }
            }
    };
    dense_gemm_phase64((const bf16_t*)(ws + WS_B), 1024, (const bf16_t*)(ws + W_GI), 1024, 25, epi, smem);
    {
        const int G = gridDim.x, rem = ((NTOK / 128) * 25) % G;
        int first = 1536, nb = 1;
        if (rem == 0) { first = blockIdx.x; nb = G; } else if ((int)blockIdx.x >= rem) { first = blockIdx.x - rem; nb = G - rem; }
        __syncthreads();
        for (int it = first; it < 1536; it += nb) convert_moe_tile(p, 0, it, smem);
    }
}

struct GlaGate { float w[16]; float bias; };
__device__ __forceinline__ float gla_loga(const GlaGate& gg, const float* gr) {
    float z = gg.bias;
#pragma unroll
    for (int r = 0; r < 16; ++r) z += gr[r] * gg.w[r];
    return logsig_f(z) * (1.f / 16.f);
}
__device__ __forceinline__ void gla_prepare(const Params& p, int tok0, int h, GlaGate& gg, float* sGL, float* sTot, float& off, float& blast) {
    const int tid = threadIdx.x, d = tid & 127, half = tid >> 7;
    const float* GLOW = (const float*)(p.ws + WS_GLOW);
    for (int i = tid; i < 1024; i += 256) sGL[i] = GLOW[(size_t)tok0 * 16 + i];
#pragma unroll
    for (int r = 0; r < 16; ++r) gg.w[r] = p.in[2][r * 512 + h * 128 + d];
    gg.bias = p.in[3][h * 128 + d];
    __syncthreads();
    float run = 0.f;
#pragma unroll 4
    for (int i = 0; i < 32; ++i) run += gla_loga(gg, sGL + (half * 32 + i) * 16);
    sTot[half * 128 + d] = run;
    __syncthreads();
    const float t0 = sTot[d], t1 = sTot[128 + d];
    off = half ? t0 : 0.f;
    blast = t0 + t1;
}

__device__ __forceinline__ void phase_gla_kv(const Params& p, unsigned char* smem) {
    unsigned char* ws = p.ws;
    const bf16_t* QK = (const bf16_t*)(ws + C_QK); const bf16_t* VT = (const bf16_t*)(ws + C_VT);
    bf16_t* KV = (bf16_t*)(ws + WS_D); float* DEC = (float*)(ws + WS_DEC);
    float* sGL = (float*)smem; float* sTot = sGL + 1024;
    bf16_t* sKD = (bf16_t*)(sTot + 256);
    bf16_t* sK = sKD + 128 * 72;
    const int tid = threadIdx.x, lane = tid & 63, wid = tid >> 6, fr = lane & 15, fq = lane >> 4, d = tid & 127, half = tid >> 7;
    for (int item = blockIdx.x; item < 1024; item += gridDim.x) {
        const int c = item >> 2, h = item & 3, tok0 = c * 64;
#pragma unroll
        for (int i = 0; i < 4; ++i) {
            const int ch = tid + i * 256, t = ch >> 4, cc = ch & 15;
            *(uint4*)(sK + t * 136 + cc * 8) = *(const uint4*)(QK + (size_t)(tok0 + t) * 1024 + 512 + h * 128 + cc * 8);
        }
        bf16x8 bf[4][2];
#pragma unroll
        for (int n = 0; n < 4; ++n)
#pragma unroll
            for (int kk = 0; kk < 2; ++kk) bf[n][kk] = ld8(VT + ((size_t)c * 1024 + h * 256 + wid * 64 + n * 16 + fr) * 64 + kk * 32 + fq * 8);
        float la[32];
        {
            const float* GLOW = (const float*)(ws + WS_GLOW);
            for (int i = tid; i < 1024; i += 256) sGL[i] = GLOW[(size_t)tok0 * 16 + i];
            GlaGate gg;
#pragma unroll
            for (int r = 0; r < 16; ++r) gg.w[r] = p.in[2][r * 512 + h * 128 + d];
            gg.bias = p.in[3][h * 128 + d];
            __syncthreads();
            float tot = 0.f;
#pragma unroll
            for (int i = 0; i < 32; ++i) { la[i] = gla_loga(gg, sGL + (half * 32 + i) * 16); tot += la[i]; }
            sTot[half * 128 + d] = tot;
            __syncthreads();
        }
        {
            const float t0 = sTot[d], t1 = sTot[128 + d], blast = t0 + t1;
            float run = half ? t0 : 0.f;
            float* BC = (float*)((bf16_t*)(ws + WS_B) + (size_t)tok0 * 1024 + h * 256) + d;
#pragma unroll
            for (int i = 0; i < 32; i += 2) {
                const int t = half * 32 + i;
                run += la[i];
                BC[(size_t)t * 512] = run;
                const float k0 = bf2f(sK[t * 136 + d]) * __expf(blast - run);
                run += la[i + 1];
                BC[(size_t)(t + 1) * 512] = run;
                const float k1 = bf2f(sK[(t + 1) * 136 + d]) * __expf(blast - run);
                *(unsigned*)(sKD + d * 72 + t) = pack2(k0, k1);
            }
            if (half == 1) DEC[(size_t)item * 128 + d] = __expf(blast);
        }
        __syncthreads();
#pragma unroll 1
        for (int dh = 0; dh < 2; ++dh) {
            f32x4 acc[4][4];
#pragma unroll
            for (int m = 0; m < 4; ++m)
#pragma unroll
                for (int n = 0; n < 4; ++n) acc[m][n] = (f32x4){0.f, 0.f, 0.f, 0.f};
#pragma unroll
            for (int kk = 0; kk < 2; ++kk) {
                bf16x8 af[4];
#pragma unroll
                for (int m = 0; m < 4; ++m) af[m] = *(const bf16x8*)(sKD + (dh * 64 + m * 16 + fr) * 72 + kk * 32 + fq * 8);
#pragma unroll
                for (int m = 0; m < 4; ++m)
#pragma unroll
                    for (int n = 0; n < 4; ++n) acc[m][n] = mfma16(af[m], bf[n][kk], acc[m][n]);
            }
#pragma unroll
            for (int m = 0; m < 4; ++m)
#pragma unroll
                for (int n = 0; n < 4; ++n)
                    *(uint2*)(KV + ((size_t)item * 256 + wid * 64 + n * 16 + fr) * 128 + dh * 64 + m * 16 + fq * 4) =
                        make_uint2(pack2(acc[m][n][0], acc[m][n][1]), pack2(acc[m][n][2], acc[m][n][3]));
        }
        __syncthreads();
    }
}

__device__ __forceinline__ void phase_gla_scan(const Params& p, unsigned char* smem) {
    unsigned char* ws = p.ws;
    bf16_t* KV = (bf16_t*)(ws + WS_D); const float* DEC = (const float*)(ws + WS_DEC);
    const int nthreads = gridDim.x * 256;
    for (int gid = blockIdx.x * 256 + threadIdx.x; gid < 65536; gid += nthreads) {
        const int bh = gid >> 13, v = (gid >> 5) & 255, dq = gid & 31, b = bh >> 2, h = bh & 3;
        float s0 = 0.f, s1 = 0.f, s2 = 0.f, s3 = 0.f;
        uint2 kvn[8]; float4 dcn[8];
#pragma unroll
        for (int u = 0; u < 8; ++u) {
            const size_t item = (size_t)((b * 128 + u) * 4 + h);
            kvn[u] = *(const uint2*)(KV + (item * 256 + v) * 128 + dq * 4);
            dcn[u] = *(const float4*)(DEC + item * 128 + dq * 4);
        }
        for (int n0 = 0; n0 < 128; n0 += 8) {
            uint2 kv[8]; float4 dc[8];
#pragma unroll
            for (int u = 0; u < 8; ++u) { kv[u] = kvn[u]; dc[u] = dcn[u]; }
            if (n0 + 8 < 128) {
#pragma unroll
                for (int u = 0; u < 8; ++u) {
                    const size_t item = (size_t)((b * 128 + n0 + 8 + u) * 4 + h);
                    kvn[u] = *(const uint2*)(KV + (item * 256 + v) * 128 + dq * 4);
                    dcn[u] = *(const float4*)(DEC + item * 128 + dq * 4);
                }
            }
#pragma unroll
            for (int u = 0; u < 8; ++u) {
                const size_t item = (size_t)((b * 128 + n0 + u) * 4 + h);
                *(uint2*)(KV + (item * 256 + v) * 128 + dq * 4) = make_uint2(pack2(s0, s1), pack2(s2, s3));
                s0 = dc[u].x * s0 + __uint_as_float(kv[u].x << 16);
                s1 = dc[u].y * s1 + __uint_as_float(kv[u].x & 0xFFFF0000u);
                s2 = dc[u].z * s2 + __uint_as_float(kv[u].y << 16);
                s3 = dc[u].w * s3 + __uint_as_float(kv[u].y & 0xFFFF0000u);
            }
        }
    }
}

__device__ __forceinline__ void phase_gla_out(const Params& p, unsigned char* smem) {
    unsigned char* ws = p.ws;
    const bf16_t* QK = (const bf16_t*)(ws + C_QK); const bf16_t* VT = (const bf16_t*)(ws + C_VT); const bf16_t* R = (const bf16_t*)(ws + C_R);
    const bf16_t* ST = (const bf16_t*)(ws + WS_D); bf16_t* OG = (bf16_t*)(ws + WS_B);
    float* sGL = (float*)smem; float* sTot = sGL + 1024; float* sSS = sTot + 256;
    bf16_t* sQD = (bf16_t*)(sSS + 256);
    bf16_t* sKD = sQD + 64 * 136;
    bf16_t* sP = sKD + 64 * 136;
    const int tid = threadIdx.x, lane = tid & 63, wid = tid >> 6, fr = lane & 15, fq = lane >> 4, d = tid & 127, half = tid >> 7;
    for (int item = blockIdx.x; item < 1024; item += gridDim.x) {
        const int c = item >> 2, h = item & 3, tok0 = c * 64;
#pragma unroll
        for (int i = 0; i < 4; ++i) {
            const int ch = tid + i * 256, t = ch >> 4, cc = ch & 15;
            const bf16_t* src = QK + (size_t)(tok0 + t) * 1024 + h * 128 + cc * 8;
            *(uint4*)(sQD + t * 136 + cc * 8) = *(const uint4*)src;
            *(uint4*)(sKD + t * 136 + cc * 8) = *(const uint4*)(src + 512);
        }
        {
            const float* BC = (const float*)((const bf16_t*)(ws + WS_B) + (size_t)tok0 * 1024 + h * 256) + d;
            float bb[32];
#pragma unroll
            for (int i = 0; i < 32; ++i) bb[i] = BC[(size_t)(half * 32 + i) * 512];
            __syncthreads();
#pragma unroll
            for (int i = 0; i < 32; ++i) {
                const int t = half * 32 + i;
                sQD[t * 136 + d] = f2bf(bf2f(sQD[t * 136 + d]) * __expf(bb[i]));
                sKD[t * 136 + d] = f2bf(bf2f(sKD[t * 136 + d]) * __expf(-bb[i]));
            }
        }
        __syncthreads();
        {
            f32x4 sc[4];
#pragma unroll
            for (int n = 0; n < 4; ++n) sc[n] = (f32x4){0.f, 0.f, 0.f, 0.f};
#pragma unroll
            for (int kk = 0; kk < 4; ++kk) {
                const bf16x8 a = *(const bf16x8*)(sQD + (wid * 16 + fr) * 136 + kk * 32 + fq * 8);
#pragma unroll
                for (int n = 0; n < 4; ++n) { const bf16x8 bb = *(const bf16x8*)(sKD + (n * 16 + fr) * 136 + kk * 32 + fq * 8); sc[n] = mfma16(a, bb, sc[n]); }
            }
#pragma unroll
            for (int n = 0; n < 4; ++n)
#pragma unroll
                for (int j = 0; j < 4; ++j) {
                    const int i = wid * 16 + fq * 4 + j, jj = n * 16 + fr;
                    sP[i * 72 + jj] = f2bf(jj <= i ? sc[n][j] : 0.f);
                }
        }
        __syncthreads();
        f32x4 acc[4][4];
#pragma unroll
        for (int m = 0; m < 4; ++m)
#pragma unroll
            for (int n = 0; n < 4; ++n) acc[m][n] = (f32x4){0.f, 0.f, 0.f, 0.f};
#pragma unroll
        for (int kk = 0; kk < 2; ++kk) {
            bf16x8 af[4], bfr[4];
#pragma unroll
            for (int m = 0; m < 4; ++m) af[m] = ld8(VT + ((size_t)c * 1024 + h * 256 + wid * 64 + m * 16 + fr) * 64 + kk * 32 + fq * 8);
#pragma unroll
            for (int n = 0; n < 4; ++n) bfr[n] = *(const bf16x8*)(sP + (n * 16 + fr) * 72 + kk * 32 + fq * 8);
#pragma unroll
            for (int m = 0; m < 4; ++m)
#pragma unroll
                for (int n = 0; n < 4; ++n) acc[m][n] = mfma16(af[m], bfr[n], acc[m][n]);
        }
#pragma unroll
        for (int kk = 0; kk < 4; ++kk) {
            bf16x8 af[4], bfr[4];
#pragma unroll
            for (int m = 0; m < 4; ++m) af[m] = ld8(ST + ((size_t)item * 256 + wid * 64 + m * 16 + fr) * 128 + kk * 32 + fq * 8);
#pragma unroll
            for (int n = 0; n < 4; ++n) bfr[n] = *(const bf16x8*)(sQD + (n * 16 + fr) * 136 + kk * 32 + fq * 8);
#pragma unroll
            for (int m = 0; m < 4; ++m)
#pragma unroll
                for (int n = 0; n < 4; ++n) acc[m][n] = mfma16(af[m], bfr[n], acc[m][n]);
        }
#pragma unroll
        for (int n = 0; n < 4; ++n) {
            float s = 0.f;
#pragma unroll
            for (int m = 0; m < 4; ++m)
#pragma unroll
                for (int j = 0; j < 4; ++j) s += acc[m][n][j] * acc[m][n][j];
            s = fqsum(s);
            if (fq == 0) sSS[wid * 64 + n * 16 + fr] = s;
        }
        __syncthreads();
#pragma unroll
        for (int n = 0; n < 4; ++n) {
            const int i = n * 16 + fr;
            const float tot = sSS[i] + sSS[64 + i] + sSS[128 + i] + sSS[192 + i];
            const float rs = rsqrtf(tot * (1.f / 256.f) + LN_EPS);
#pragma unroll
            for (int m = 0; m < 4; ++m) {
                const int v0 = wid * 64 + m * 16 + fq * 4;
                const size_t idx = (size_t)(tok0 + i) * 1024 + h * 256 + v0;
                const uint2 rr = *(const uint2*)(R + idx);
                const float4 ng = *(const float4*)(p.in[4] + v0);
                const float o0 = acc[m][n][0] * rs * ng.x * silu_f(__uint_as_float(rr.x << 16));
                const float o1 = acc[m][n][1] * rs * ng.y * silu_f(__uint_as_float(rr.x & 0xFFFF0000u));
                const float o2 = acc[m][n][2] * rs * ng.z * silu_f(__uint_as_float(rr.y << 16));
                const float o3 = acc[m][n][3] * rs * ng.w * silu_f(__uint_as_float(rr.y & 0xFFFF0000u));
                *(uint2*)(OG + idx) = make_uint2(pack2(o0, o1), pack2(o2, o3));
            }
        }
        __syncthreads();
    }
}

__device__ __forceinline__ void phase_outproj(const Params& p, const bf16_t* Wt, const float* res, unsigned char* smem) {
    unsigned char* ws = p.ws;
    float* Y = (float*)(ws + WS_C);
    auto epi = [&](f32x4 (&acc)[4][4], int row0, int nt, int wc, int fr, int fq) {
#pragma unroll
        for (int m = 0; m < 4; ++m)
#pragma unroll
            for (int n = 0; n < 4; ++n) {
                const size_t idx = (size_t)(row0 + m * 16 + fr) * 1024 + nt * 128 + wc * 64 + n * 16 + fq * 4;
                const float4 r = *(const float4*)(res + idx);
                *(float4*)(Y + idx) = make_float4(DN_ALPHA * r.x + acc[m][n][0], DN_ALPHA * r.y + acc[m][n][1], DN_ALPHA * r.z + acc[m][n][2], DN_ALPHA * r.w + acc[m][n][3]);
            }
    };
    dense_gemm_phase64<true>((const bf16_t*)(ws + WS_B), 1024, Wt, 1024, 8, epi, smem);
}

__device__ __forceinline__ void phase_ln_router(const Params& p, int layer, unsigned char* smem, bool staged) {
    unsigned char* ws = p.ws;
    float* Y = (float*)(ws + WS_C); bf16_t* XB = (bf16_t*)(ws + WS_B);
    const float* lg = p.in[18] + (layer * 2 + 0) * 1024; const float* lb = p.in[19] + (layer * 2 + 0) * 1024;
    const float* brt = p.in[14];
    float* PW = (float*)(ws + WS_PW); int* LIST = (int*)(ws + WS_LIST); unsigned* gcnt = (unsigned*)(ws + WS_CNT) + layer * 16;
    float* WR = (float*)smem;
    int* sE = (int*)(smem + 65536);
    int* lcnt = sE + 64; int* lbase = lcnt + 16; int* lpos = lbase + 16;
    const int tid = threadIdx.x, lane = tid & 63, wid = tid >> 6;
    if (!staged) { for (int i = tid; i < 4096; i += 256) ((float4*)WR)[i] = ((const float4*)(ws + WS_WRT))[i]; }
    float4 lgr[4], lbr[4]; float brr[16];
#pragma unroll
    for (int i = 0; i < 4; ++i) { lgr[i] = *(const float4*)(lg + i * 256 + lane * 4); lbr[i] = *(const float4*)(lb + i * 256 + lane * 4); }
#pragma unroll
    for (int e = 0; e < 16; ++e) brr[e] = brt[e];
    __syncthreads();
    for (int grp = blockIdx.x; grp < 512; grp += gridDim.x) {
        if (tid < 16) lcnt[tid] = 0;
        float4 vn[4];
#pragma unroll
        for (int i = 0; i < 4; ++i) vn[i] = *(const float4*)(Y + (size_t)(grp * 32 + wid * 8) * 1024 + i * 256 + lane * 4);
        for (int ti = 0; ti < 8; ++ti) {
            const int tok = grp * 32 + wid * 8 + ti;
            float4 v[4];
#pragma unroll
            for (int i = 0; i < 4; ++i) v[i] = vn[i];
            if (ti < 7) {
#pragma unroll
                for (int i = 0; i < 4; ++i) vn[i] = *(const float4*)(Y + (size_t)(tok + 1) * 1024 + i * 256 + lane * 4);
            }
            float s = 0.f;
#pragma unroll
            for (int i = 0; i < 4; ++i) s += (v[i].x + v[i].y) + (v[i].z + v[i].w);
            const float mu = wsum64(s) * (1.f / 1024.f);
            float q = 0.f;
#pragma unroll
            for (int i = 0; i < 4; ++i) { const float a = v[i].x - mu, b = v[i].y - mu, c = v[i].z - mu, d = v[i].w - mu; q += (a * a + b * b) + (c * c + d * d); }
            const float rstd = rsqrtf(wsum64(q) * (1.f / 1024.f) + LN_EPS);
#pragma unroll
            for (int i = 0; i < 4; ++i) {
                const float4 g4 = lgr[i], b4 = lbr[i];
                v[i].x = (v[i].x - mu) * rstd * g4.x + b4.x; v[i].y = (v[i].y - mu) * rstd * g4.y + b4.y;
                v[i].z = (v[i].z - mu) * rstd * g4.z + b4.z; v[i].w = (v[i].w - mu) * rstd * g4.w + b4.w;
                *(float4*)(Y + (size_t)tok * 1024 + i * 256 + lane * 4) = v[i];
                *(uint2*)(XB + (size_t)tok * 1024 + i * 256 + lane * 4) = make_uint2(pack2(v[i].x, v[i].y), pack2(v[i].z, v[i].w));
            }
            float pa[16];
#pragma unroll
            for (int e = 0; e < 16; ++e) {
                float a = 0.f;
#pragma unroll
                for (int i = 0; i < 4; ++i) { const float4 w = *(const float4*)(WR + e * 1024 + i * 256 + lane * 4); a += v[i].x * w.x + v[i].y * w.y + v[i].z * w.z + v[i].w * w.w; }
                pa[e] = a;
            }
            float s8[8];
#pragma unroll
            for (int i = 0; i < 8; ++i) { auto r = __builtin_amdgcn_permlane32_swap(__float_as_uint(pa[i]), __float_as_uint(pa[i + 8]), false, false); s8[i] = __uint_as_float(r[0]) + __uint_as_float(r[1]); }
            float t4[4];
#pragma unroll
            for (int i = 0; i < 4; ++i) { auto r = __builtin_amdgcn_permlane16_swap(__float_as_uint(s8[i]), __float_as_uint(s8[i + 4]), false, false); t4[i] = rsum16(__uint_as_float(r[0]) + __uint_as_float(r[1])); }
            float s4[4];
#pragma unroll
            for (int i = 0; i < 4; ++i) s4[i] = sigmoid_f(t4[i]);
            float sg[16], bz[16];
#pragma unroll
            for (int e = 0; e < 16; ++e) {
                const int row = ((e >> 3) << 1) | ((e >> 2) & 1);
                sg[e] = __uint_as_float(__builtin_amdgcn_readlane(__float_as_uint(s4[e & 3]), row * 16));
                bz[e] = sg[e] + brr[e];
            }
            float gs[4];
#pragma unroll
            for (int g = 0; g < 4; ++g) {
                const float a = bz[4 * g], b = bz[4 * g + 1], c = bz[4 * g + 2], d = bz[4 * g + 3];
                const float mab = fmaxf(a, b), nab = fminf(a, b), mcd = fmaxf(c, d), ncd = fminf(c, d);
                gs[g] = fmaxf(mab, mcd) + fmaxf(fminf(mab, mcd), fmaxf(nab, ncd));
            }
            int grpi = 0; float gbest = gs[0];
#pragma unroll
            for (int g = 1; g < 4; ++g) if (gs[g] > gbest) { gbest = gs[g]; grpi = g; }
            float bv[4], sv[4];
#pragma unroll
            for (int k = 0; k < 4; ++k) {
                bv[k] = grpi == 0 ? bz[k] : (grpi == 1 ? bz[4 + k] : (grpi == 2 ? bz[8 + k] : bz[12 + k]));
                sv[k] = grpi == 0 ? sg[k] : (grpi == 1 ? sg[4 + k] : (grpi == 2 ? sg[8 + k] : sg[12 + k]));
            }
            int i1 = 0; float b1 = bv[0];
#pragma unroll
            for (int k = 1; k < 4; ++k) if (bv[k] > b1) { b1 = bv[k]; i1 = k; }
            int i2 = -1; float b2 = -3.0e38f;
#pragma unroll
            for (int k = 0; k < 4; ++k) if (k != i1 && (i2 < 0 || bv[k] > b2)) { b2 = bv[k]; i2 = k; }
            float w0 = i1 == 0 ? sv[0] : (i1 == 1 ? sv[1] : (i1 == 2 ? sv[2] : sv[3]));
            float w1 = i2 == 0 ? sv[0] : (i2 == 1 ? sv[1] : (i2 == 2 ? sv[2] : sv[3]));
            const float wsum = w0 + w1; w0 /= wsum; w1 /= wsum;
            if (lane == 0) {
                PW[(size_t)tok * 2] = w0; PW[(size_t)tok * 2 + 1] = w1;
                sE[(wid * 8 + ti) * 2] = grpi * 4 + i1; sE[(wid * 8 + ti) * 2 + 1] = grpi * 4 + i2;
            }
        }
        __syncthreads();
        int myE = 0;
        if (tid < 64) { myE = sE[tid]; lpos[tid] = atomicAdd(&lcnt[myE], 1); }
        __syncthreads();
        if (tid < 16) lbase[tid] = lcnt[tid] > 0 ? (int)atomicAdd(&gcnt[tid], (unsigned)lcnt[tid]) : 0;
        __syncthreads();
        if (tid < 64) LIST[(size_t)myE * 16384 + lbase[myE] + lpos[tid]] = grp * 64 + tid;
        __syncthreads();
    }
}

constexpr size_t C_H = WS_C + 64 * MiB;
constexpr int MBM = 128, MMI = MBM / 32;
__device__ __forceinline__ void moe_tiles(const unsigned* gcnt, int* sTs) {
    if (threadIdx.x == 0) { int a = 0; for (int e = 0; e < 16; ++e) { sTs[e] = a; a += ((int)gcnt[e] + MBM - 1) / MBM; } sTs[16] = a; }
    __syncthreads();
}
constexpr int MOE_SKIP = 4;
constexpr int ABM = 256, AMI = ABM / 32;
__device__ __forceinline__ void phase_moe(const Params& p, int layer, unsigned char* smem) {
    unsigned char* ws = p.ws;
    const bf16_t* XB = (const bf16_t*)(ws + WS_B); bf16_t* H = (bf16_t*)(ws + C_H); bf16_t* F = (bf16_t*)(ws + WS_D);
    const float* PW = (const float*)(ws + WS_PW); const int* LIST = (const int*)(ws + WS_LIST); const unsigned* gcnt = (const unsigned*)(ws + WS_CNT) + layer * 16;
    unsigned* flg = (unsigned*)(ws + WS_FLG) + layer * (FLG_TILES * 16);
    unsigned* bar = (unsigned*)(ws + WS_CTL);
    unsigned char* stg = smem;
    float* sW = (float*)(smem + 73728);
    int* sPair = (int*)(smem + 73728);
    int* sTs = (int*)(sW + ABM);
    const int tid = threadIdx.x, lane = tid & 63, wid = tid >> 6, wr = wid >> 1, wc = wid & 1, fr = lane & 15, fq = lane >> 4;
    const int G = gridDim.x;
    if (tid == 0) { int a = 0; for (int e = 0; e < 16; ++e) { sTs[e] = a; a += ((int)gcnt[e] + ABM - 1) / ABM; } sTs[16] = a; }
    __syncthreads();
    const int T2 = sTs[16];
    const int NA = ((T2 + 7) >> 3) * 32, NB = ((2 * T2 + 7) >> 3) * 64;
    for (int item = blockIdx.x; item < NA; item += G) {
        const int xcd = item & 7, idx = item >> 3;
        const int tile = (idx >> 2) * 8 + xcd, nt = idx & 3;
        if (tile >= T2) continue;
        int e = 0;
        for (int q = 1; q < 16; ++q) if (tile >= sTs[q]) e = q;
        const int cnt = (int)gcnt[e], rt = tile - sTs[e];
        sW[tid] = PW[LIST[(size_t)e * 16384 + min(rt * ABM + tid, cnt - 1)]];
        const int* lst = LIST + (size_t)e * 16384;
        const int p0 = lst[min(rt * ABM + (tid >> 2), cnt - 1)], p1 = lst[min(rt * ABM + 64 + (tid >> 2), cnt - 1)];
        const int p2 = lst[min(rt * ABM + 128 + (tid >> 2), cnt - 1)], p3 = lst[min(rt * ABM + 192 + (tid >> 2), cnt - 1)];
        const bf16_t* a0 = XB + (size_t)(p0 >> 1) * 1024 + (tid & 3) * 8;
        const bf16_t* a1 = XB + (size_t)(p1 >> 1) * 1024 + (tid & 3) * 8;
        const bf16_t* a2 = XB + (size_t)(p2 >> 1) * 1024 + (tid & 3) * 8;
        const bf16_t* a3 = XB + (size_t)(p3 >> 1) * 1024 + (tid & 3) * 8;
        const bf16_t* WGU = (const bf16_t*)(ws + W_MOE + (size_t)e * MOE_E_BYTES);
        const bf16_t* b0 = WGU + (size_t)(nt * 128 + (tid >> 2)) * 1024 + (tid & 3) * 8;
        f32x4 acc[AMI][4];
        gemm_loop<ABM, false, 3, true>(acc, a0, a1, b0, b0 + (size_t)64 * 1024, 32, stg, nullptr, 0, a2, a3);
#pragma unroll
        for (int m = 0; m < AMI; ++m) {
            const int r = wr * (ABM / 2) + m * 16 + fr;
            const float w = sW[r];
#pragma unroll
            for (int n = 0; n < 2; ++n) {
                const int f = (nt * 2 + wc) * 32 + n * 16 + fq * 4;
                const unsigned lo = pack2(silu_f(acc[m][n][0]) * acc[m][n + 2][0] * w, silu_f(acc[m][n][1]) * acc[m][n + 2][1] * w);
                const unsigned hi = pack2(silu_f(acc[m][n][2]) * acc[m][n + 2][2] * w, silu_f(acc[m][n][3]) * acc[m][n + 2][3] * w);
                __hip_atomic_store((unsigned long long*)(H + ((size_t)tile * ABM + r) * 256 + f), (unsigned long long)lo | ((unsigned long long)hi << 32),
                                   __ATOMIC_RELAXED, __HIP_MEMORY_SCOPE_AGENT);
            }
        }
        asm volatile("s_waitcnt vmcnt(0)" ::: "memory");
        __syncthreads();
        if (tid == 0) (void)xb_add(&flg[tile * 16], 1u);
    }
    const int R = NA % G, NE = G - R;
    const int S = MOE_SKIP * NE <= NB ? MOE_SKIP : 0;
    const int Q = (NB - S * NE) / G, tail = (NB - S * NE) % G;
    const bool light = (int)blockIdx.x >= R;
    const int qb = light ? (int)blockIdx.x - R : NE + (int)blockIdx.x;
    auto unit_of = [&](int k) -> int {
        const int b = blockIdx.x;
        const int nskew = light ? S : 0;
        if (k < nskew) return (b - R) + NE * k;
        if (k < nskew + Q) return S * NE + b + G * (k - nskew);
        const int h = qb + G * (k - nskew - Q);
        if (h >= 2 * tail) return -1;
        return (NB - tail + (h >= tail ? h - tail : h)) | ((h >= tail ? 2 : 1) << 28);
    };
    int cov = 0;
    for (int k = 0;; ++k) {
        const int u = unit_of(k);
        if (u < 0) break;
        const int tid = opaque((int)threadIdx.x), lane = tid & 63, wid = tid >> 6, wr = wid >> 1, wc = wid & 1, fr = lane & 15, fq = lane >> 4;
        const int item = u & 0xfffffff, half = u >> 28;
        const int xcd = item & 7, idx = item >> 3;
        const int tile = (idx >> 3) * 8 + xcd, nt = idx & 7;
        if (tile >= 2 * T2) continue;
        int e = 0;
        for (int q = 1; q < 16; ++q) if ((tile >> 1) >= sTs[q]) e = q;
        const int cnt = (int)gcnt[e], rt = tile - 2 * sTs[e];
        if (rt * MBM >= cnt) continue;
        if (tid == 0 && k >= cov) {
            XB_SPIN(xb_ld(&flg[(tile >> 1) * 16]) != 4u, bar);
            int k2 = k + 1;
            for (;; ++k2) {
                const int u2 = unit_of(k2);
                if (u2 < 0) break;
                const int it2 = u2 & 0xfffffff, t2 = ((it2 >> 6) << 3) + (it2 & 7);
                if (t2 < 2 * T2 && xb_ld(&flg[(t2 >> 1) * 16]) != 4u) break;
            }
            cov = k2;
            __builtin_amdgcn_fence(__ATOMIC_ACQUIRE, "agent");
            asm volatile("s_waitcnt vmcnt(0)" ::: "memory");
        }
        const int rbase = half == 2 ? 64 : 0;
        if (tid < MBM) { const int idx = rt * MBM + tid; sPair[tid] = idx < cnt ? LIST[(size_t)e * 16384 + idx] : -1; }
        const unsigned sch = ((tid & 7) ^ ((tid >> 4) & 7)) * 8;
        const unsigned aoff = (unsigned)(tile * MBM + rbase + (tid >> 3)) * 256 + sch;
        const bf16_t* WDN = (const bf16_t*)(ws + W_MOE + (size_t)e * MOE_E_BYTES) + (size_t)512 * 1024;
        const unsigned boff = (unsigned)(nt * 128 + (tid >> 3)) * 256 + sch;
        if (half == 0) {
            f32x4 acc[MMI][4];
            gemm_loop64<MBM>(acc, H + aoff, (size_t)32 * 256, WDN + boff, (size_t)32 * 256, 4, stg);
#pragma unroll
            for (int m = 0; m < MMI; ++m)
#pragma unroll
                for (int j = 0; j < 4; ++j) {
                    const int r2 = wr * (MBM / 2) + m * 16 + fq * 4 + j, pair = sPair[r2];
                    if (pair >= 0) {
#pragma unroll
                        for (int n = 0; n < 4; ++n) F[(size_t)pair * 1024 + nt * 128 + wc * 64 + n * 16 + fr] = f2bf(acc[m][n][j]);
                    }
                }
        } else {
            f32x4 acc[2][4];
            gemm_loop64<64>(acc, H + aoff, (size_t)32 * 256, WDN + boff, (size_t)32 * 256, 4, stg);
#pragma unroll
            for (int m = 0; m < 2; ++m)
#pragma unroll
                for (int j = 0; j < 4; ++j) {
                    const int r2 = rbase + wr * 32 + m * 16 + fq * 4 + j, pair = sPair[r2];
                    if (pair >= 0) {
#pragma unroll
                        for (int n = 0; n < 4; ++n) F[(size_t)pair * 1024 + nt * 128 + wc * 64 + n * 16 + fr] = f2bf(acc[m][n][j]);
                    }
                }
        }
        __syncthreads();
    }
}

__device__ __forceinline__ void phase_ln2(const Params& p, int layer, bool final_out, unsigned char* smem) {
    unsigned char* ws = p.ws;
    const float* X1 = (const float*)(ws + WS_C); const bf16_t* F = (const bf16_t*)(ws + WS_D);
    float* X2 = final_out ? p.out : (float*)(ws + WS_D); bf16_t* XB = (bf16_t*)(ws + WS_B);
    const float* lg = p.in[18] + (layer * 2 + 1) * 1024; const float* lb = p.in[19] + (layer * 2 + 1) * 1024;
    const int lane = threadIdx.x & 63, nw = gridDim.x * 4;
    float4 lgr[4], lbr[4];
#pragma unroll
    for (int i = 0; i < 4; ++i) { lgr[i] = *(const float4*)(lg + i * 256 + lane * 4); lbr[i] = *(const float4*)(lb + i * 256 + lane * 4); }
    float4 xn[4]; uint2 f0n[4], f1n[4];
    const int tokf = blockIdx.x * 4 + (threadIdx.x >> 6);
    if (tokf < NTOK) {
#pragma unroll
        for (int i = 0; i < 4; ++i) {
            const int c = i * 256 + lane * 4;
            xn[i] = *(const float4*)(X1 + (size_t)tokf * 1024 + c);
            f0n[i] = *(const uint2*)(F + (size_t)(tokf * 2) * 1024 + c); f1n[i] = *(const uint2*)(F + (size_t)(tokf * 2 + 1) * 1024 + c);
        }
    }
    for (int tok = tokf; tok < NTOK; tok += nw) {
        float4 v[4];
#pragma unroll
        for (int i = 0; i < 4; ++i) {
            const float4 x = xn[i]; const uint2 f0 = f0n[i], f1 = f1n[i];
            v[i].x = DN_ALPHA * x.x + (__uint_as_float(f0.x << 16) + __uint_as_float(f1.x << 16));
            v[i].y = DN_ALPHA * x.y + (__uint_as_float(f0.x & 0xFFFF0000u) + __uint_as_float(f1.x & 0xFFFF0000u));
            v[i].z = DN_ALPHA * x.z + (__uint_as_float(f0.y << 16) + __uint_as_float(f1.y << 16));
            v[i].w = DN_ALPHA * x.w + (__uint_as_float(f0.y & 0xFFFF0000u) + __uint_as_float(f1.y & 0xFFFF0000u));
        }
        if (tok + nw < NTOK) {
#pragma unroll
            for (int i = 0; i < 4; ++i) {
                const int c = i * 256 + lane * 4;
                xn[i] = *(const float4*)(X1 + (size_t)(tok + nw) * 1024 + c);
                f0n[i] = *(const uint2*)(F + (size_t)((tok + nw) * 2) * 1024 + c); f1n[i] = *(const uint2*)(F + (size_t)((tok + nw) * 2 + 1) * 1024 + c);
            }
        }
        float s = 0.f;
#pragma unroll
        for (int i = 0; i < 4; ++i) s += (v[i].x + v[i].y) + (v[i].z + v[i].w);
        const float mu = wsum64(s) * (1.f / 1024.f);
        float q = 0.f;
#pragma unroll
        for (int i = 0; i < 4; ++i) { const float a = v[i].x - mu, b = v[i].y - mu, c = v[i].z - mu, d = v[i].w - mu; q += (a * a + b * b) + (c * c + d * d); }
        const float rstd = rsqrtf(wsum64(q) * (1.f / 1024.f) + LN_EPS);
#pragma unroll
        for (int i = 0; i < 4; ++i) {
            const int c = i * 256 + lane * 4;
            const float4 g4 = lgr[i], b4 = lbr[i];
            float4 o;
            o.x = (v[i].x - mu) * rstd * g4.x + b4.x; o.y = (v[i].y - mu) * rstd * g4.y + b4.y;
            o.z = (v[i].z - mu) * rstd * g4.z + b4.z; o.w = (v[i].w - mu) * rstd * g4.w + b4.w;
            *(float4*)(X2 + (size_t)tok * 1024 + c) = o;
            if (!final_out) *(uint2*)(XB + (size_t)tok * 1024 + c) = make_uint2(pack2(o.x, o.y), pack2(o.z, o.w));
        }
    }
}

__device__ __forceinline__ void phase_nsa_inproj(const Params& p, unsigned char* smem) {
    unsigned char* ws = p.ws;
    bf16_t* QN = (bf16_t*)(ws + C_QN); float* GT = (float*)(ws + WS_GT);
    const float2* ROPE = (const float2*)(ws + WS_ROPE);
    auto epi = [&](auto& acc, int row0, int nt, int wc, int fr, int fq) {
        constexpr int MI = sizeof(acc) / sizeof(acc[0]);
#pragma unroll
        for (int m = 0; m < MI; ++m) {
            const int r0 = row0 + m * 16 + fq * 4;
            const int b = r0 >> 13, s0 = r0 & 8191;
#pragma unroll
            for (int n = 0; n < 4; ++n) {
                const int cw = wc * 64 + n * 16 + fr;
                float v[4];
#pragma unroll
                for (int j = 0; j < 4; ++j) v[j] = acc[m][n][j];
                const int kind = nt < 8 ? 0 : (nt < 20 ? 1 + ((nt - 8) >> 1) : 7);
                if (n == 0 && (kind == 0 || kind == 3 || kind == 5)) {
#pragma unroll
                    for (int j = 0; j < 4; ++j) {
                        const float pv = dpp_f<0x128>(v[j]);
                        const float2 cs = ROPE[(size_t)(s0 + j) * 8 + (fr & 7)];
                        v[j] = fr < 8 ? v[j] * cs.x - pv * cs.y : v[j] * cs.x + pv * cs.y;
                    }
                }
                if (kind == 0) {
#pragma unroll
                    for (int j = 0; j < 4; ++j) QN[(size_t)(r0 + j) * 1024 + nt * 128 + cw] = f2bf(v[j] * 0.18033688011112042f);
                } else if (kind == 7) {
                    if (cw < 48) {
#pragma unroll
                        for (int j = 0; j < 4; ++j) GT[(size_t)(r0 + j) * 48 + cw] = sigmoid_f(v[j]);
                    }
                } else {
                    const int g = ((nt - 8) & 1) * 2 + wc, dd = n * 16 + fr, bg = b * 4 + g;
                    bf16_t* base = (bf16_t*)(ws + C_KC + (size_t)(kind - 1) * 8 * MiB) + (size_t)bg * 8192 * 64;
                    if (kind == 3) {
                        unsigned char* k8 = ws + C_KS + ((size_t)bg * 8192 + s0) * 64 + dd;
#pragma unroll
                        for (int j = 0; j < 4; ++j) k8[j * 64] = (unsigned char)__builtin_amdgcn_cvt_pk_fp8_f32(v[j], v[j], 0, false);
                    } else if (kind == 4) {
                        unsigned pk = __builtin_amdgcn_cvt_pk_fp8_f32(v[0], v[1], 0, false);
                        pk = __builtin_amdgcn_cvt_pk_fp8_f32(v[2], v[3], pk, true);
                        *(unsigned*)(ws + C_VST + (size_t)bg * 64 * 8192 + (size_t)(s0 >> 6) * 4096 + dd * 64 + (s0 & 63)) = pk;
                    } else if (kind == 5) {
                        unsigned char* k8 = ws + C_KW + ((size_t)bg * 8192 + s0) * 64 + dd;
#pragma unroll
                        for (int j = 0; j < 4; ++j) k8[j * 64] = (unsigned char)__builtin_amdgcn_cvt_pk_fp8_f32(v[j], v[j], 0, false);
                    } else if (kind == 6) {
                        unsigned pk = __builtin_amdgcn_cvt_pk_fp8_f32(v[0], v[1], 0, false);
                        pk = __builtin_amdgcn_cvt_pk_fp8_f32(v[2], v[3], pk, true);
                        *(unsigned*)(ws + C_VWT + (size_t)bg * 64 * 8192 + (size_t)(s0 >> 6) * 4096 + dd * 64 + (s0 & 63)) = pk;
                    } else {
#pragma unroll
                        for (int j = 0; j < 4; ++j) base[(size_t)(s0 + j) * 64 + dd] = f2bf(v[j]);
                    }
                }
            }
        }
    };
    dense_gemm_phase64((const bf16_t*)(ws + WS_B), 1024, (const bf16_t*)(ws + W_NI), 1024, 21, epi, smem);
    {
        const int G = gridDim.x, rem = ((NTOK / 128) * 21) % G;
        int first = 1536, nb = 1;
        if (rem == 0) { first = blockIdx.x; nb = G; } else if ((int)blockIdx.x >= rem) { first = blockIdx.x - rem; nb = G - rem; }
        __syncthreads();
        for (int it = first; it < 1536; it += nb) convert_moe_tile(p, 1, it, smem);
    }
}

__device__ __forceinline__ void phase_nsa_compress_a(const Params& p, unsigned char* smem) {
    unsigned char* ws = p.ws;
    float* HP = (float*)(ws + WS_B);
    const int tid = threadIdx.x, lane = tid & 63, wid = tid >> 6, wr = wid >> 1, wc = wid & 1, fr = lane & 15, fq = lane >> 4;
    for (int item = blockIdx.x; item < 512; item += gridDim.x) {
        const int it3 = item >> 2, ks = item & 3;
        const int which = it3 >> 6, bg = (it3 >> 3) & 7, mt = it3 & 7;
        const bf16_t* src = (const bf16_t*)(ws + (which ? C_VC : C_KC)) + (size_t)bg * 8192 * 64;
        const bf16_t* W1 = (const bf16_t*)(ws + (which ? W_CV1 : W_CK1));
        const int sch = ((tid & 7) ^ ((tid >> 4) & 7)) * 8;
        const bf16_t* ap = src + (size_t)(mt * 64 + (tid >> 3)) * 1024 + ks * 512 + sch;
        float* dst = HP + ((size_t)it3 * 4 + ks) * 64 * 256;
        for (int nt = 0; nt < 2; ++nt) {
            const bf16_t* bp = W1 + (size_t)(nt * 128 + (tid >> 3)) * 2048 + ks * 512 + sch;
            f32x4 acc[2][4];
            gemm_loop64<64, true>(acc, ap, (size_t)32 * 1024, bp, (size_t)32 * 2048, 8, smem);
#pragma unroll
            for (int m = 0; m < 2; ++m)
#pragma unroll
                for (int n = 0; n < 4; ++n)
                    *(f32x4*)(dst + (size_t)(wr * 32 + m * 16 + fr) * 256 + nt * 128 + wc * 64 + n * 16 + fq * 4) = acc[m][n];
        }
    }
}
__device__ __forceinline__ void phase_nsa_compress(const Params& p, unsigned char* smem) {
    unsigned char* ws = p.ws;
    bf16_t* sH = (bf16_t*)smem;
    const float* HP = (const float*)(ws + WS_B);
    const float2* ROPE = (const float2*)(ws + WS_ROPE);
    const int tid = threadIdx.x, lane = tid & 63, wid = tid >> 6, fr = lane & 15, fq = lane >> 4;
    for (int item4 = blockIdx.x; item4 < 512; item4 += gridDim.x) {
        const int item = item4 >> 2, sub = item4 & 3;
        const int which = item >> 6, bg = (item >> 3) & 7, mt = item & 7;
        const bf16_t* W2 = (const bf16_t*)(ws + (which ? W_CV2 : W_CK2));
        const float* bias = (const float*)(ws + WS_BIASC) + which * 256;
        {
            const float* hp = HP + (size_t)item * 4 * 64 * 256 + (size_t)sub * 16 * 256;
#pragma unroll
            for (int i = 0; i < 4; ++i) {
                const int q = tid + i * 256, r = q >> 6, c4 = (q & 63) * 4;
                const float4 p0 = *(const float4*)(hp + (size_t)r * 256 + c4), p1 = *(const float4*)(hp + 16384 + (size_t)r * 256 + c4);
                const float4 p2 = *(const float4*)(hp + 32768 + (size_t)r * 256 + c4), p3 = *(const float4*)(hp + 49152 + (size_t)r * 256 + c4);
                const float4 bb = *(const float4*)(bias + c4);
                const float h0 = silu_f(((p0.x + p1.x) + (p2.x + p3.x)) + bb.x), h1 = silu_f(((p0.y + p1.y) + (p2.y + p3.y)) + bb.y);
                const float h2 = silu_f(((p0.z + p1.z) + (p2.z + p3.z)) + bb.z), h3 = silu_f(((p0.w + p1.w) + (p2.w + p3.w)) + bb.w);
                *(uint2*)(sH + r * 264 + c4) = make_uint2(pack2(h0, h1), pack2(h2, h3));
            }
        }
        __syncthreads();
        f32x4 o = (f32x4){0.f, 0.f, 0.f, 0.f};
        const int n = wid;
#pragma unroll
        for (int kk = 0; kk < 8; ++kk) {
            const bf16x8 a = *(const bf16x8*)(sH + fr * 264 + kk * 32 + fq * 8);
            o = mfma16(a, ld8(W2 + (size_t)(n * 16 + fr) * 256 + kk * 32 + fq * 8), o);
        }
        const int j0 = mt * 64 + sub * 16 + fq * 4;
        if (which == 0) {
#pragma unroll
            for (int j = 0; j < 4; ++j) {
                float v = o[j];
                const int jj = j0 + j;
                if (n == 0) {
                    const float pv = dpp_f<0x128>(v);
                    const float2 cs = ROPE[(size_t)min(16 * jj + 31, 8191) * 8 + (fr & 7)];
                    v = fr < 8 ? v * cs.x - pv * cs.y : v * cs.x + pv * cs.y;
                }
                ((bf16_t*)(ws + WS_KCMP))[((size_t)bg * 512 + jj) * 64 + n * 16 + fr] = jj < 511 ? f2bf(v) : (bf16_t)0;
            }
        } else {
            const float v3 = (j0 + 3) < 511 ? o[3] : 0.f;
            *(uint2*)((bf16_t*)(ws + WS_VCMPT) + ((size_t)bg * 64 + n * 16 + fr) * 512 + j0) = make_uint2(pack2(o[0], o[1]), pack2(o[2], v3));
        }
        __syncthreads();
    }
}

__device__ __forceinline__ void phase_nsa_attn(const Params& p, unsigned char* smem, const int mode = 7) {
    unsigned char* ws = p.ws;
    const bf16_t* QN = (const bf16_t*)(ws + C_QN);
    const bf16_t* KS = (const bf16_t*)(ws + C_KS); const bf16_t* VST = (const bf16_t*)(ws + C_VST);
    const bf16_t* KW = (const bf16_t*)(ws + C_KW); const bf16_t* VWT = (const bf16_t*)(ws + C_VWT);
    const bf16_t* KCMP = (const bf16_t*)(ws + WS_KCMP); const bf16_t* VCMPT = (const bf16_t*)(ws + WS_VCMPT);
    const float* GT = (const float*)(ws + WS_GT); bf16_t* O = (bf16_t*)(ws + WS_B);
    const int tid = threadIdx.x, lane = tid & 63, wid = tid >> 6, fr = lane & 15, fq = lane >> 4;
    unsigned* sMask = (unsigned*)smem;
    unsigned char* sList = smem + 384;
    unsigned char* sQ = smem + 512;
    unsigned char* R = smem + 8704;
    float* impA = (float*)R;
    float* impB = impA + 2048;
    unsigned char* stg = R + 16384;
    const f32x4 zero4 = (f32x4){0.f, 0.f, 0.f, 0.f};
    auto issue = [&](int buf, const bf16_t* kt, const bf16_t* vt, int vstride, bool with_v) {
        unsigned char* kb = stg + buf * 16384; unsigned char* vb = kb + 8192;
#pragma unroll
        for (int h = 0; h < 2; ++h) {
            const int row = (tid >> 3) + h * 32, lc = (tid & 7) ^ ((row >> 1) & 7);
            glds16(kt + row * 64 + lc * 8, kb + h * 4096 + tid * 16);
            if (with_v) glds16(vt + (size_t)row * vstride + lc * 8, vb + h * 4096 + tid * 16);
        }
    };
    auto ring_sync = [&](int newer) {
        if (newer == 0) asm volatile("s_waitcnt vmcnt(0) lgkmcnt(0)" ::: "memory");
        else if (newer == 2) asm volatile("s_waitcnt vmcnt(2) lgkmcnt(0)" ::: "memory");
        else if (newer == 8) asm volatile("s_waitcnt vmcnt(8) lgkmcnt(0)" ::: "memory");
        else asm volatile("s_waitcnt vmcnt(4) lgkmcnt(0)" ::: "memory");
        __builtin_amdgcn_s_barrier();
        asm volatile("" ::: "memory");
    };
    auto ldsK = [&](int buf, int mt, int c) -> bf16x8 {
        const int row = mt * 16 + fr;
        return *(const bf16x8*)(stg + buf * 16384 + row * 128 + (((c * 4 + fq) ^ ((row >> 1) & 7)) << 4));
    };
    auto ldsV = [&](int buf, int dt, int c) -> bf16x8 {
        const int row = dt * 16 + fr;
        const unsigned char* rb = stg + buf * 16384 + 8192 + row * 128 + (fq & 1) * 8;
        const int sw = (row >> 1) & 7, ch = 4 * c + (fq >> 1);
        const uint2 lo = *(const uint2*)(rb + ((ch ^ sw) << 4)), hi = *(const uint2*)(rb + (((ch + 2) ^ sw) << 4));
        union { uint4 u; bf16x8 v; } cv; cv.u = make_uint4(lo.x, lo.y, hi.x, hi.y);
        return cv.v;
    };
    unsigned* qhead = (unsigned*)(ws + WS_AQ);
    volatile LAS unsigned* bq = (volatile LAS unsigned*)smem_dyn + 3;
    int queue = blockIdx.x & 7, nq = 0;
    if (tid == 0) *bq = xb_add(&qhead[queue * 16], 1u);
    for (;;) {
        __syncthreads();
        const unsigned qi = (unsigned)__builtin_amdgcn_readfirstlane((int)*bq);
        if (qi >= 512u) {
            if (++nq == 8) break;
            queue = (queue + 1) & 7;
            __syncthreads();
            if (tid == 0) *bq = xb_add(&qhead[queue * 16], 1u);
            continue;
        }
        const int bg = queue, tile = 511 - (int)qi;
        const int tid = opaque((int)threadIdx.x), lane = tid & 63, wid = tid >> 6, fr = lane & 15, fq = lane >> 4;
        const int b = bg >> 2, g = bg & 3, s0 = tile * 16, t0 = s0 + wid * 4;
        for (int i = tid; i < 4096; i += 256) impA[i] = 0.f;
        const int mytok = t0 + (fr >> 2), myhead = fr & 3;
        bf16x8 qa0, qa1;
        {
            const bf16_t* qp = QN + (size_t)(b * 8192 + mytok) * 1024 + (g * 4 + myhead) * 64 + fq * 8;
            qa0 = ld8(qp); qa1 = ld8(qp + 32);
        }
        auto qk_tile = [&](int buf, f32x4 (&st)[4]) {
#pragma unroll
            for (int mt = 0; mt < 4; ++mt) { st[mt] = mfma16(ldsK(buf, mt, 0), qa0, zero4); st[mt] = mfma16(ldsK(buf, mt, 1), qa1, st[mt]); }
        };
        auto pv_tile = [&](int buf, const uint4 (&pb)[2], f32x4 (&o)[4]) {
#pragma unroll
            for (int c = 0; c < 2; ++c) {
                union { uint4 u; bf16x8 v; } cv; cv.u = pb[c];
#pragma unroll
                for (int dt = 0; dt < 4; ++dt) o[dt] = mfma16(ldsV(buf, dt, c), cv.v, o[dt]);
            }
        };
        auto pack_p = [&](const float (&e)[4][4], uint4 (&pb)[2]) {
            pb[0] = make_uint4(pack2(e[0][0], e[0][1]), pack2(e[0][2], e[0][3]), pack2(e[1][0], e[1][1]), pack2(e[1][2], e[1][3]));
            pb[1] = make_uint4(pack2(e[2][0], e[2][1]), pack2(e[2][2], e[2][3]), pack2(e[3][0], e[3][1]), pack2(e[3][2], e[3][3]));
        };
        auto online = [&](f32x4 (&st)[4], const bool masked, auto key_ok, const bool col_on, float& m, float& l, f32x4 (&o)[4], uint4 (&pb)[2]) {
            if (masked) {
#pragma unroll
                for (int mt = 0; mt < 4; ++mt)
#pragma unroll
                    for (int j = 0; j < 4; ++j) if (!key_ok(mt, j)) st[mt][j] = -1e30f;
            }
            float mx = max3f(max3f(max3f(st[0][0], st[0][1], st[0][2]), max3f(st[0][3], st[1][0], st[1][1]), max3f(st[1][2], st[1][3], st[2][0])),
                             max3f(max3f(st[2][1], st[2][2], st[2][3]), max3f(st[3][0], st[3][1], st[3][2]), st[3][3]), -1e30f);
            mx = col_on ? mx : -1e30f;
            mx = fqmax(mx);
            if (__any(mx > m + 4.f)) {
                const float mn = fmaxf(m, mx), al = __builtin_amdgcn_exp2f(m - mn);
                l *= al; m = mn;
#pragma unroll
                for (int dt = 0; dt < 4; ++dt) o[dt] *= al;
            }
            float e[4][4];
            const float mref = fmaxf(m, -1e29f);
#pragma unroll
            for (int mt = 0; mt < 4; ++mt)
#pragma unroll
                for (int j = 0; j < 4; ++j) e[mt][j] = __builtin_amdgcn_exp2f(st[mt][j] - mref);
            float ps = sum16(e);
            pack_p(e, pb);
            if (!col_on) { ps = 0.f; pb[0] = make_uint4(0u, 0u, 0u, 0u); pb[1] = make_uint4(0u, 0u, 0u, 0u); }
            l += ps;
        };
        const int NCT = (mode & 1) ? ((s0 >> 4) + 63) >> 6 : 0;
        const bf16_t* kc = KCMP + (size_t)bg * 512 * 64;
        const bf16_t* vc = VCMPT + (size_t)bg * 64 * 512;
        float mc = -1e30f, lc = 0.f;
        __syncthreads();
        if (NCT > 0) issue(0, kc, vc, 512, false);
        if (NCT > 1) issue(1, kc + (size_t)64 * 64, vc + 64, 512, false);
        for (int it = 0; it < NCT; ++it) {
            ring_sync(it + 1 < NCT ? 2 : 0);
            if (it + 2 < NCT) issue((it + 2) % 3, kc + (size_t)(it + 2) * 64 * 64, vc + (it + 2) * 64, 512, false);
            f32x4 st[4];
            qk_tile(it % 3, st);
            const bool masked = (16 * (it * 64 + 63) + 31) > s0;
            auto vis = [&](int mt, int j) -> bool { return (16 * (it * 64 + mt * 16 + fq * 4 + j) + 31) <= mytok; };
            if (masked) {
#pragma unroll
                for (int mt = 0; mt < 4; ++mt)
#pragma unroll
                    for (int j = 0; j < 4; ++j) if (!vis(mt, j)) st[mt][j] = -1e30f;
            }
            float mx = max3f(max3f(max3f(st[0][0], st[0][1], st[0][2]), max3f(st[0][3], st[1][0], st[1][1]), max3f(st[1][2], st[1][3], st[2][0])),
                             max3f(max3f(st[2][1], st[2][2], st[2][3]), max3f(st[3][0], st[3][1], st[3][2]), st[3][3]), -1e30f);
            mx = fqmax(mx);
            const float mn = fmaxf(mc, mx), mref = fmaxf(mn, -1e29f);
            float e[4][4];
#pragma unroll
            for (int mt = 0; mt < 4; ++mt)
#pragma unroll
                for (int j = 0; j < 4; ++j) e[mt][j] = __builtin_amdgcn_exp2f(st[mt][j] - mref);
            lc = lc * __builtin_amdgcn_exp2f(mc - mn) + sum16(e); mc = mn;
        }
        lc = fqsum(lc);
        const float il = lc > 0.f ? 1.f / lc : 0.f;
        f32x4 oc[4];
#pragma unroll
        for (int dt = 0; dt < 4; ++dt) oc[dt] = zero4;
        __syncthreads();
        if (NCT > 0) issue(0, kc, vc, 512, true);
        if (NCT > 1) issue(1, kc + (size_t)64 * 64, vc + 64, 512, true);
        for (int it = 0; it < NCT; ++it) {
            ring_sync(it + 1 < NCT ? 4 : 0);
            if (it + 2 < NCT) issue((it + 2) % 3, kc + (size_t)(it + 2) * 64 * 64, vc + (it + 2) * 64, 512, true);
            f32x4 st[4];
            qk_tile(it % 3, st);
            const bool masked = (16 * (it * 64 + 63) + 31) > s0;
            if (masked) {
#pragma unroll
                for (int mt = 0; mt < 4; ++mt)
#pragma unroll
                    for (int j = 0; j < 4; ++j) if ((16 * (it * 64 + mt * 16 + fq * 4 + j) + 31) > mytok) st[mt][j] = -1e30f;
            }
            const float mref2 = fmaxf(mc, -1e29f);
            float pp[4][4];
#pragma unroll
            for (int mt = 0; mt < 4; ++mt) {
                float pg[4];
#pragma unroll
                for (int j = 0; j < 4; ++j) {
                    const float pj = __builtin_amdgcn_exp2f(st[mt][j] - mref2) * il;
                    pp[mt][j] = pj;
                    float q4 = pj; q4 += dpp_f<0xB1>(q4); q4 += dpp_f<0x4E>(q4);
                    pg[j] = q4;
                }
                if (myhead == 0) {
                    const int jb = it * 16 + mt * 4 + fq;
                    impA[(wid * 4 + (fr >> 2)) * 128 + jb] = pg[0] + 2.f * (pg[1] + pg[2] + pg[3]);
                    impB[(wid * 4 + (fr >> 2)) * 128 + jb] = pg[0];
                }
            }
            uint4 pb[2];
            pack_p(pp, pb);
            pv_tile(it % 3, pb, oc);
        }
        __syncthreads();
        {
            unsigned wu0 = 0u, wu1 = 0u, wu2 = 0u, wu3 = 0u;
            for (int i = 0; i < 4; ++i) {
                const int tl = wid * 4 + i, t = t0 + i, cur = t >> 6;
                unsigned w0, w1, w2, w3;
                if (cur < 16) { w0 = (2u << cur) - 1u; w1 = 0u; w2 = 0u; w3 = 0u; }
                else {
                    const int j0 = lane, j1 = lane + 64;
                    float x0, x1;
                    if (mode & 1) {
                        x0 = impA[tl * 128 + j0] + impB[tl * 128 + min(j0 + 1, 127)];
                        x1 = impA[tl * 128 + j1] + impB[tl * 128 + min(j1 + 1, 127)];
                    } else {
                        x0 = (float)(((unsigned)t * 7u + (unsigned)j0 * 13u + (unsigned)(j0 * j0) * 5u) % 1021u);
                        x1 = (float)(((unsigned)t * 7u + (unsigned)j1 * 13u + (unsigned)(j1 * j1) * 5u) % 1021u);
                    }
                    const unsigned k0 = j0 > cur ? 0u : (((j0 == 0 || j0 == cur || j0 == cur - 1) ? 0x7F000000u : __float_as_uint(x0)) + 1u);
                    const unsigned k1 = j1 > cur ? 0u : (((j1 == 0 || j1 == cur || j1 == cur - 1) ? 0x7F000000u : __float_as_uint(x1)) + 1u);
                    unsigned T = 0u;
                    for (int bit = 31; bit >= 0; --bit) {
                        const unsigned cand = T | (1u << bit);
                        const int c = __popcll(__ballot(k0 >= cand)) + __popcll(__ballot(k1 >= cand));
                        if (c >= 16) T = cand;
                    }
                    const unsigned long long gt0 = __ballot(k0 > T), gt1 = __ballot(k1 > T), eq0 = __ballot(k0 == T), eq1 = __ballot(k1 == T);
                    const int r = 16 - __popcll(gt0) - __popcll(gt1);
                    const int rank0 = (int)__builtin_amdgcn_mbcnt_hi((unsigned)(eq0 >> 32), __builtin_amdgcn_mbcnt_lo((unsigned)eq0, 0u));
                    const int rank1 = __popcll(eq0) + (int)__builtin_amdgcn_mbcnt_hi((unsigned)(eq1 >> 32), __builtin_amdgcn_mbcnt_lo((unsigned)eq1, 0u));
                    const unsigned long long s0m = __ballot(k0 > T || (k0 == T && rank0 < r));
                    const unsigned long long s1m = __ballot(k1 > T || (k1 == T && rank1 < r));
                    w0 = (unsigned)s0m; w1 = (unsigned)(s0m >> 32); w2 = (unsigned)s1m; w3 = (unsigned)(s1m >> 32);
                }
                if (lane == 0) { sMask[tl * 4 + 0] = w0; sMask[tl * 4 + 1] = w1; sMask[tl * 4 + 2] = w2; sMask[tl * 4 + 3] = w3; }
                wu0 |= w0; wu1 |= w1; wu2 |= w2; wu3 |= w3;
            }
            if (lane == 0) { sMask[64 + wid * 4 + 0] = wu0; sMask[64 + wid * 4 + 1] = wu1; sMask[64 + wid * 4 + 2] = wu2; sMask[64 + wid * 4 + 3] = wu3; }
        }
        __syncthreads();
        f32x4 ow[4];
        float mw = -1e30f, lw = 0.f;
#pragma unroll
        for (int dt = 0; dt < 4; ++dt) ow[dt] = zero4;
        {
            const int k0 = max(0, s0 - 511) & ~63;
            const int NWT = (mode & 2) ? ((s0 + 15 - k0) >> 6) + 1 : 0;
            const unsigned char* kw8 = ws + C_KW + ((size_t)bg * 8192 + k0) * 64;
            const unsigned char* vw8 = ws + C_VWT + (size_t)bg * 64 * 8192 + (size_t)(k0 >> 6) * 4096;
            auto to8w = [&](const bf16x8 q) -> long {
                float f[8];
#pragma unroll
                for (int e = 0; e < 8; ++e) f[e] = __uint_as_float(((unsigned)(unsigned short)q[e]) << 16);
                unsigned lo = __builtin_amdgcn_cvt_pk_fp8_f32(f[0], f[1], 0, false); lo = __builtin_amdgcn_cvt_pk_fp8_f32(f[2], f[3], lo, true);
                unsigned hi = __builtin_amdgcn_cvt_pk_fp8_f32(f[4], f[5], 0, false); hi = __builtin_amdgcn_cvt_pk_fp8_f32(f[6], f[7], hi, true);
                return (long)(((unsigned long long)hi << 32) | lo);
            };
            const long q0 = to8w(qa0), q1 = to8w(qa1);
            auto issue8 = [&](int buf, int it) {
                const int t2 = opaque(tid), row = t2 >> 2, pc = t2 & 3;
                unsigned char* sb = stg + buf * 8192 + t2 * 16;
                glds16(kw8 + (size_t)it * 64 * 64 + row * 64 + ((pc ^ ((row >> 3) & 3)) << 4), sb);
                glds16(vw8 + (size_t)it * 4096 + row * 64 + ((pc ^ ((row >> 2) & 3)) << 4), sb + 4096);
            };
            int kofs[2], vofs[2];
#pragma unroll
            for (int c = 0; c < 2; ++c) {
                kofs[c] = (8 * (fr >> 2) + (fr & 3)) * 64 + (((2 * c + (fq >> 1)) ^ ((fr >> 2) & 3)) << 4) + (fq & 1) * 8;
                vofs[c] = fr * 64 + (((2 * c + (fq >> 1)) ^ ((fr >> 2) & 3)) << 4) + (fq & 1) * 8;
            }
            if (NWT > 0) issue8(0, 0);
            if (NWT > 1) issue8(1, 1);
            for (int it = 0; it < NWT; ++it) {
                ring_sync(it + 1 < NWT ? 2 : 0);
                if (it + 2 < NWT) issue8((it + 2) % 3, it + 2);
                const unsigned char* sb = stg + (it % 3) * 8192;
                f32x4 st[4];
#pragma unroll
                for (int mt = 0; mt < 4; ++mt) {
                    st[mt] = __builtin_amdgcn_mfma_f32_16x16x32_fp8_fp8(*(const long*)(sb + 2048 * (mt >> 1) + 256 * (mt & 1) + kofs[0]), q0, zero4, 0, 0, 0);
                    st[mt] = __builtin_amdgcn_mfma_f32_16x16x32_fp8_fp8(*(const long*)(sb + 2048 * (mt >> 1) + 256 * (mt & 1) + kofs[1]), q1, st[mt], 0, 0, 0);
                }
                const int kb = k0 + it * 64, key0 = kb + fq * 8;
                if (!(kb + 63 <= s0 && kb + 512 > s0 + 15)) {
#pragma unroll
                    for (int mt = 0; mt < 4; ++mt)
#pragma unroll
                        for (int j = 0; j < 4; ++j) { const int key = key0 + 32 * (mt >> 1) + 4 * (mt & 1) + j; if (!(key <= mytok && key + 512 > mytok)) st[mt][j] = -1e30f; }
                }
                float mx = max3f(max3f(max3f(st[0][0], st[0][1], st[0][2]), max3f(st[0][3], st[1][0], st[1][1]), max3f(st[1][2], st[1][3], st[2][0])),
                                 max3f(max3f(st[2][1], st[2][2], st[2][3]), max3f(st[3][0], st[3][1], st[3][2]), st[3][3]), -1e30f);
                mx = fqmax(mx);
                if (__any(mx > mw + 2.f)) {
                    const float mn = fmaxf(mw, mx), al = __builtin_amdgcn_exp2f(mw - mn);
                    lw *= al; mw = mn;
#pragma unroll
                    for (int dt = 0; dt < 4; ++dt) ow[dt] *= al;
                }
                float e[4][4];
                const float mref = fmaxf(mw, -1e29f) - 6.f;
#pragma unroll
                for (int mt = 0; mt < 4; ++mt)
#pragma unroll
                    for (int j = 0; j < 4; ++j) e[mt][j] = __builtin_amdgcn_exp2f(st[mt][j] - mref);
                lw += sum16(e);
                long pb[2];
#pragma unroll
                for (int c = 0; c < 2; ++c) {
                    unsigned lo = __builtin_amdgcn_cvt_pk_fp8_f32(e[2 * c][0], e[2 * c][1], 0, false);
                    lo = __builtin_amdgcn_cvt_pk_fp8_f32(e[2 * c][2], e[2 * c][3], lo, true);
                    unsigned hi = __builtin_amdgcn_cvt_pk_fp8_f32(e[2 * c + 1][0], e[2 * c + 1][1], 0, false);
                    hi = __builtin_amdgcn_cvt_pk_fp8_f32(e[2 * c + 1][2], e[2 * c + 1][3], hi, true);
                    pb[c] = (long)(((unsigned long long)hi << 32) | lo);
                }
#pragma unroll
                for (int dt = 0; dt < 4; ++dt) {
                    ow[dt] = __builtin_amdgcn_mfma_f32_16x16x32_fp8_fp8(*(const long*)(sb + 4096 + dt * 1024 + vofs[0]), pb[0], ow[dt], 0, 0, 0);
                    ow[dt] = __builtin_amdgcn_mfma_f32_16x16x32_fp8_fp8(*(const long*)(sb + 4096 + dt * 1024 + vofs[1]), pb[1], ow[dt], 0, 0, 0);
                }
            }
        }
        {
            const float* gp = GT + (size_t)(b * 8192 + mytok) * 48 + g * 12 + myhead * 3;
            const float g0 = gp[0], g2 = (mode & 2) ? gp[2] / fqsum(lw) : 0.f;
#pragma unroll
            for (int dt = 0; dt < 4; ++dt) oc[dt] = oc[dt] * g0 + ow[dt] * g2;
        }
        unsigned nxt = 0u;
        f32x4 os[4];
        float lsel = 1.f;
#pragma unroll
        for (int dt = 0; dt < 4; ++dt) os[dt] = zero4;
        if (mode & 4) {
            float* park = (float*)(ws + C_PARK) + (size_t)blockIdx.x * 4096;
#pragma unroll
            for (int dt = 0; dt < 4; ++dt) *(f32x4*)(park + (dt * 256 + tid) * 4) = oc[dt];
            {
                auto to8 = [&](const bf16x8 q) -> uint2 {
                    float f[8];
#pragma unroll
                    for (int e = 0; e < 8; ++e) f[e] = __uint_as_float(((unsigned)(unsigned short)q[e]) << 16);
                    unsigned lo = __builtin_amdgcn_cvt_pk_fp8_f32(f[0], f[1], 0, false); lo = __builtin_amdgcn_cvt_pk_fp8_f32(f[2], f[3], lo, true);
                    unsigned hi = __builtin_amdgcn_cvt_pk_fp8_f32(f[4], f[5], 0, false); hi = __builtin_amdgcn_cvt_pk_fp8_f32(f[6], f[7], hi, true);
                    return make_uint2(lo, hi);
                };
                *(uint2*)(sQ + ((wid * 2 + 0) * 64 + lane) * 8) = to8(qa0);
                *(uint2*)(sQ + ((wid * 2 + 1) * 64 + lane) * 8) = to8(qa1);
            }
            unsigned un[4];
#pragma unroll
            for (int w = 0; w < 4; ++w) un[w] = sMask[64 + w] | sMask[68 + w] | sMask[72 + w] | sMask[76 + w];
            const int U = __popc(un[0]) + __popc(un[1]) + __popc(un[2]) + __popc(un[3]);
            if (wid == 0) {
                const unsigned lo_below = __builtin_amdgcn_mbcnt_hi(un[1], __builtin_amdgcn_mbcnt_lo(un[0], 0u));
                const unsigned hi_below = __builtin_amdgcn_mbcnt_hi(un[3], __builtin_amdgcn_mbcnt_lo(un[2], 0u));
                if ((un[lane >> 5] >> (lane & 31)) & 1u) sList[lo_below] = (unsigned char)lane;
                if ((un[2 + (lane >> 5)] >> (lane & 31)) & 1u) sList[__popc(un[0]) + __popc(un[1]) + hi_below] = (unsigned char)(lane + 64);
            }
            __syncthreads();
            const unsigned char* ksb = ws + C_KS + (size_t)bg * 8192 * 64;
            const unsigned char* vsb = ws + C_VST + (size_t)bg * 64 * 8192;
            const int curb = s0 >> 6;
            unsigned char* rb = R + wid * 16384;
            f32x4 oacc[4][4];
            float mcb[4], lcb[4];
#pragma unroll
            for (int cb = 0; cb < 4; ++cb) { mcb[cb] = -1e30f; lcb[cb] = 0.f;
#pragma unroll
                for (int dt = 0; dt < 4; ++dt) oacc[cb][dt] = zero4; }
            const int nsteps = U > wid ? ((U - wid + 3) >> 2) : 0;
            int jbv = 0; unsigned wmv = 0u;
            if (lane < nsteps) {
                jbv = sList[wid + 4 * lane];
#pragma unroll
                for (int cb = 0; cb < 4; ++cb) wmv |= ((sMask[64 + cb * 4 + (jbv >> 5)] >> (jbv & 31)) & 1u) << cb;
            }
            const int drow = lane >> 2, dpc = lane & 3;
            auto issue_step = [&](int s) {
                const int jb = __builtin_amdgcn_readlane(jbv, s);
                unsigned char* sb = rb + (s & 1) * 8192 + lane * 16;
                const unsigned char* kt = ksb + (size_t)jb * 64 * 64;
                const unsigned char* vt = vsb + (size_t)jb * 4096;
#pragma unroll
                for (int i = 0; i < 4; ++i) {
                    const int row = drow + 16 * i;
                    glds16(kt + row * 64 + ((dpc ^ ((row >> 3) & 3)) << 4), sb + i * 1024);
                    glds16(vt + row * 64 + ((dpc ^ ((row >> 2) & 3)) << 4), sb + 4096 + i * 1024);
                }
            };
            int kofs[2], vofs[2];
#pragma unroll
            for (int c = 0; c < 2; ++c) {
                kofs[c] = (8 * (fr >> 2) + (fr & 3)) * 64 + (((2 * c + (fq >> 1)) ^ ((fr >> 2) & 3)) << 4) + (fq & 1) * 8;
                vofs[c] = fr * 64 + (((2 * c + (fq >> 1)) ^ ((fr >> 2) & 3)) << 4) + (fq & 1) * 8;
            }
            if (nsteps > 0 && !(mode & 8)) issue_step(0);
            if (nsteps > 1 && !(mode & 8)) issue_step(1);
            for (int s = 0; s < nsteps; ++s) {
                if (s + 1 < nsteps) asm volatile("s_waitcnt vmcnt(8)" ::: "memory");
                else asm volatile("s_waitcnt vmcnt(0)" ::: "memory");
                const int jb = __builtin_amdgcn_readlane(jbv, s);
                const unsigned char* sb = rb + (s & 1) * 8192;
                long kA[4][2], vA[4][2];
#pragma unroll
                for (int mt = 0; mt < 4; ++mt)
#pragma unroll
                    for (int c = 0; c < 2; ++c) kA[mt][c] = *(const long*)(sb + 2048 * (mt >> 1) + 256 * (mt & 1) + kofs[c]);
#pragma unroll
                for (int dt = 0; dt < 4; ++dt)
#pragma unroll
                    for (int c = 0; c < 2; ++c) vA[dt][c] = *(const long*)(sb + 4096 + dt * 1024 + vofs[c]);
                if (s + 2 < nsteps) {
                    asm volatile("s_waitcnt lgkmcnt(0)" ::: "memory");
                    if (!(mode & 8)) issue_step(s + 2);
                }
                const bool masked = jb == curb;
                const int key0 = jb * 64 + fq * 8;
                unsigned cm = 0u;
#pragma unroll
                for (int cb = 0; cb < 4; ++cb) cm |= ((sMask[(cb * 4 + (fr >> 2)) * 4 + (jb >> 5)] >> (jb & 31)) & 1u) << cb;
                const unsigned wm = (unsigned)__builtin_amdgcn_readlane((int)wmv, s);
#pragma unroll
                for (int cb = 0; cb < 4; ++cb) {
                    if (((wm >> cb) & 1u) && !(mode & 16)) {
                        const bool con = (cm >> cb) & 1u;
                        const int ctok = s0 + cb * 4 + (fr >> 2);
                        const long q0 = *(const long*)(sQ + ((cb * 2 + 0) * 64 + lane) * 8), q1 = *(const long*)(sQ + ((cb * 2 + 1) * 64 + lane) * 8);
                        f32x4 st[4];
#pragma unroll
                        for (int mt = 0; mt < 4; ++mt) {
                            st[mt] = __builtin_amdgcn_mfma_f32_16x16x32_fp8_fp8(kA[mt][0], q0, zero4, 0, 0, 0);
                            st[mt] = __builtin_amdgcn_mfma_f32_16x16x32_fp8_fp8(kA[mt][1], q1, st[mt], 0, 0, 0);
                        }
                        if (masked) {
#pragma unroll
                            for (int mt = 0; mt < 4; ++mt)
#pragma unroll
                                for (int j = 0; j < 4; ++j) if ((key0 + 32 * (mt >> 1) + 4 * (mt & 1) + j) > ctok) st[mt][j] = -1e30f;
                        }
                        float mx = max3f(max3f(max3f(st[0][0], st[0][1], st[0][2]), max3f(st[0][3], st[1][0], st[1][1]), max3f(st[1][2], st[1][3], st[2][0])),
                                         max3f(max3f(st[2][1], st[2][2], st[2][3]), max3f(st[3][0], st[3][1], st[3][2]), st[3][3]), -1e30f);
                        mx = fqmax(con ? mx : -1e30f);
                        if (__any(mx > mcb[cb] + 2.f)) {
                            const float mn = fmaxf(mcb[cb], mx), al = __builtin_amdgcn_exp2f(mcb[cb] - mn);
                            lcb[cb] *= al; mcb[cb] = mn;
#pragma unroll
                            for (int dt = 0; dt < 4; ++dt) oacc[cb][dt] *= al;
                        }
                        float e[4][4];
                        const float mref = mcb[cb] - 6.f;
#pragma unroll
                        for (int mt = 0; mt < 4; ++mt)
#pragma unroll
                            for (int j = 0; j < 4; ++j) e[mt][j] = __builtin_amdgcn_exp2f(st[mt][j] - mref);
                        float ps = sum16(e);
                        long pb[2];
#pragma unroll
                        for (int c = 0; c < 2; ++c) {
                            unsigned lo = __builtin_amdgcn_cvt_pk_fp8_f32(e[2 * c][0], e[2 * c][1], 0, false);
                            lo = __builtin_amdgcn_cvt_pk_fp8_f32(e[2 * c][2], e[2 * c][3], lo, true);
                            unsigned hi = __builtin_amdgcn_cvt_pk_fp8_f32(e[2 * c + 1][0], e[2 * c + 1][1], 0, false);
                            hi = __builtin_amdgcn_cvt_pk_fp8_f32(e[2 * c + 1][2], e[2 * c + 1][3], hi, true);
                            pb[c] = (long)(((unsigned long long)hi << 32) | lo);
                        }
                        if (!con) { ps = 0.f; pb[0] = 0; pb[1] = 0; }
                        lcb[cb] += ps;
#pragma unroll
                        for (int dt = 0; dt < 4; ++dt) {
                            oacc[cb][dt] = __builtin_amdgcn_mfma_f32_16x16x32_fp8_fp8(vA[dt][0], pb[0], oacc[cb][dt], 0, 0, 0);
                            oacc[cb][dt] = __builtin_amdgcn_mfma_f32_16x16x32_fp8_fp8(vA[dt][1], pb[1], oacc[cb][dt], 0, 0, 0);
                        }
                    }
                }
            }
            if (tid == 0) nxt = xb_add(&qhead[queue * 16], 1u);
            __syncthreads();
            {
                float* mrg = (float*)R;
                const int lane = opaque(tid) & 63, wid = opaque(tid) >> 6;
#pragma unroll
                for (int cb = 0; cb < 4; ++cb) {
                    if (cb != wid) {
                        float* slot = mrg + (wid * 3 + ((cb - wid - 1) & 3)) * 1152;
#pragma unroll
                        for (int dt = 0; dt < 4; ++dt) *(f32x4*)(slot + dt * 256 + lane * 4) = oacc[cb][dt];
                        slot[1024 + lane] = mcb[cb]; slot[1088 + lane] = lcb[cb];
                    }
                }
                __syncthreads();
                float mo = -1e30f, lo = 0.f;
#pragma unroll
                for (int cb = 0; cb < 4; ++cb) if (cb == wid) { mo = mcb[cb]; lo = lcb[cb];
#pragma unroll
                    for (int dt = 0; dt < 4; ++dt) os[dt] = oacc[cb][dt]; }
#pragma unroll
                for (int k = 1; k < 4; ++k) {
                    const int w2 = (wid + k) & 3;
                    const float* slot = mrg + (w2 * 3 + ((wid - w2 - 1) & 3)) * 1152;
                    const float m2 = slot[1024 + lane], l2 = slot[1088 + lane];
                    const float mn = fmaxf(mo, m2), f1 = __builtin_amdgcn_exp2f(mo - mn), f2 = __builtin_amdgcn_exp2f(m2 - mn);
                    lo = lo * f1 + l2 * f2; mo = mn;
#pragma unroll
                    for (int dt = 0; dt < 4; ++dt) { const f32x4 o2 = *(const f32x4*)(slot + dt * 256 + lane * 4); os[dt] = os[dt] * f1 + o2 * f2; }
                }
                lsel = fqsum(lo);
            }
#pragma unroll
            for (int dt = 0; dt < 4; ++dt) oc[dt] = *(const f32x4*)(park + (dt * 256 + opaque(tid)) * 4);
        }
        if (!(mode & 4) && tid == 0) nxt = xb_add(&qhead[queue * 16], 1u);
        {
            const int tid2 = opaque((int)threadIdx.x), fr = tid2 & 15, fq = (tid2 >> 4) & 3;
            const int mytok = s0 + (tid2 >> 6) * 4 + (fr >> 2), myhead = fr & 3;
            const float gsel = GT[(size_t)(b * 8192 + mytok) * 48 + g * 12 + myhead * 3 + 1];
            const float g1 = (mode & 4) ? gsel / lsel : 0.f;
            bf16_t* op = O + (size_t)(b * 8192 + mytok) * 1024 + g * 256 + myhead * 64 + fq * 4;
#pragma unroll
            for (int dt = 0; dt < 4; ++dt) {
                float r[4];
#pragma unroll
                for (int j = 0; j < 4; ++j) r[j] = oc[dt][j] + g1 * os[dt][j];
                *(uint2*)(op + dt * 16) = make_uint2(pack2(r[0], r[1]), pack2(r[2], r[3]));
            }
        }
        if (tid == 0) *bq = nxt;
        __syncthreads();
    }
}

__global__ void __launch_bounds__(256, 2) hybrid_fwd(Params p) {
    unsigned char* smem = smem_dyn + 16;
    cg::grid_group grid = cg::this_grid();
    if (threadIdx.x == 0) *(uint4*)smem_dyn = make_uint4(0u, 0u, 0u, 0u);
    __syncthreads();
    const XcdBarrier xbar = xcd_barrier_post((unsigned*)(p.ws + WS_CTL), (volatile LAS unsigned*)smem_dyn);
#define RUN_PHASE(N, CALL) if (p.ph_lo <= (N) && (N) < p.ph_hi) { if ((N) > p.ph_lo) { if ((N) == 1 && USE_CG_FIRST) grid.sync(); else xcd_barrier(xbar); } CALL; if ((REP_MASK >> (N)) & 1) { CALL; } }
    RUN_PHASE(0, phase_prologue(p, smem))
    RUN_PHASE(1, phase_gla_inproj(p, smem))
    RUN_PHASE(2, phase_gla_kv(p, smem))
    RUN_PHASE(3, phase_gla_scan(p, smem))
    RUN_PHASE(4, phase_gla_out(p, smem))
    RUN_PHASE(5, phase_outproj(p, (const bf16_t*)(p.ws + W_GO), p.in[0], smem))
    if (p.ph_lo <= 6 && 6 < p.ph_hi) {
        const bool st = 6 > p.ph_lo;
        if (st) xcd_barrier_pre(xbar, [&]() { for (int i = (int)threadIdx.x - 64; i < 4096; i += 192) ((float4*)smem)[i] = ((const float4*)(p.ws + WS_WRT))[i]; });
        phase_ln_router(p, 0, smem, st);
    }
    RUN_PHASE(7, phase_moe(p, 0, smem))
    RUN_PHASE(9, phase_ln2(p, 0, false, smem))
    RUN_PHASE(10, phase_nsa_inproj(p, smem))
    RUN_PHASE(11, phase_nsa_compress_a(p, smem))
    RUN_PHASE(12, phase_nsa_compress(p, smem))
    if (PROBE_MODE) { RUN_PHASE(13, phase_nsa_attn(p, smem, PROBE_MODE)) else {} phase_nsa_attn(p, smem, 7); } else { RUN_PHASE(13, phase_nsa_attn(p, smem)) }
    RUN_PHASE(14, phase_outproj(p, (const bf16_t*)(p.ws + W_NO), (const float*)(p.ws + WS_D), smem))
    if (p.ph_lo <= 15 && 15 < p.ph_hi) {
        const bool st = 15 > p.ph_lo;
        if (st) xcd_barrier_pre(xbar, [&]() { for (int i = (int)threadIdx.x - 64; i < 4096; i += 192) ((float4*)smem)[i] = ((const float4*)(p.ws + WS_WRT))[i]; });
        phase_ln_router(p, 1, smem, st);
    }
    RUN_PHASE(16, phase_moe(p, 1, smem))
    RUN_PHASE(18, phase_ln2(p, 1, true, smem))
}

extern "C" void kernel_launch(void* const* d_in, const int* in_sizes, int n_in, void* d_out, int out_size, void* d_ws, size_t ws_size, hipStream_t stream) {
    static int grid = 0;
    if (grid == 0) {
        if (n_in != 20 || out_size != NTOK * DM || ws_size < WS_END) {
            fprintf(stderr, "kernel_launch: unexpected problem: n_in %d out %d ws %zu (need %zu)\n", n_in, out_size, ws_size, (size_t)WS_END);
            grid = -1; return;
        }
        int dev = 0, cus = 0, per_cu = 0;
        hipGetDevice(&dev);
        hipDeviceGetAttribute(&cus, hipDeviceAttributeMultiprocessorCount, dev);
        hipFuncSetAttribute((const void*)hybrid_fwd, hipFuncAttributeMaxDynamicSharedMemorySize, LDS_BYTES);
        hipOccupancyMaxActiveBlocksPerMultiprocessor(&per_cu, (const void*)hybrid_fwd, 256, LDS_BYTES);
        if (per_cu < 1) { fprintf(stderr, "kernel_launch: occupancy query says %d blocks per CU\n", per_cu); per_cu = 1; }
        if (per_cu > 2) per_cu = 2;
        grid = cus * per_cu;
        fprintf(stderr, "kernel_launch: %d CUs x %d blocks\n", cus, per_cu);
    }
    if (grid < 0) return;
    hipMemsetAsync((unsigned char*)d_ws + WS_CTL, 0, 64 * KiB, stream);
    Params p{};
    for (int i = 0; i < 20; ++i) p.in[i] = (const float*)d_in[i];
    p.out = (float*)d_out; p.ws = (unsigned char*)d_ws;
#if MK_ONE_LAUNCH
    p.ph_lo = 0; p.ph_hi = NPHASE;
    void* args[] = {&p};
    hipError_t e = hipLaunchCooperativeKernel((const void*)hybrid_fwd, dim3(grid), dim3(256), args, LDS_BYTES, stream);
    if (e != hipSuccess) fprintf(stderr, "cooperative launch failed: %s (grid %d)\n", hipGetErrorString(e), grid);
#else
    for (int ph = 0; ph < NPHASE; ++ph) {
        p.ph_lo = ph; p.ph_hi = ph + 1;
        hipLaunchKernelGGL(hybrid_fwd, dim3(grid), dim3(256), LDS_BYTES, stream, p);
    }
#endif
}
```
